# Optimizing an MI355X kernel written in HIP

```python
import math
import jax, jax.numpy as jnp
from jax import lax
import numpy as np

D_MODEL = 1024
BATCH = 2
SEQ = 8192
DEPTH = 1

MLA_HEADS = 8
MLA_Q_RANK = 384
MLA_KV_RANK = 256
MLA_NOPE = 64
MLA_ROPE = 32
MLA_V = 64
MLA_SCALE = 1.0 / math.sqrt(MLA_NOPE + MLA_ROPE)
ROPE_THETA = 10000.0
FOX_HEADS = 8
FOX_DIM = 64
FOX_SCALE = 1.0 / math.sqrt(FOX_DIM)
D_FF = 2816
CONV_WIDTH = 3
BLOCK_Q = 128
EPS = 1e-6
N_ADA = 6

IN_SPLITS = (
    MLA_Q_RANK,
    MLA_KV_RANK,
    MLA_ROPE,
    FOX_HEADS * FOX_DIM,
    FOX_HEADS * FOX_DIM,
    FOX_HEADS * FOX_DIM,
    FOX_HEADS,
    D_MODEL,
    D_MODEL,
)
D_IN = sum(IN_SPLITS)
IN_OFFSETS = tuple(int(v) for v in np.cumsum(IN_SPLITS)[:-1])

kernel_name = "hybrid_mla_fox_convffn_adaln"


def rmsnorm(x, g):
    xf = x.astype(jnp.float32)
    y = xf * lax.rsqrt(jnp.mean(xf * xf, axis=-1, keepdims=True) + EPS)
    return (y * g.astype(jnp.float32)).astype(x.dtype)


def rope(x, positions):
    r = x.shape[-1]
    inv_freq = ROPE_THETA ** (-jnp.arange(0, r, 2, dtype=jnp.float32) / r)
    ang = positions.astype(jnp.float32)[..., None] * inv_freq
    cos = jnp.cos(ang)[:, :, None, :]
    sin = jnp.sin(ang)[:, :, None, :]
    xf = x.astype(jnp.float32)
    x1, x2 = xf[..., : r // 2], xf[..., r // 2:]
    out = jnp.concatenate([x1 * cos - x2 * sin, x2 * cos + x1 * sin], axis=-1)
    return out.astype(x.dtype)


def causal_block_attention(q, k, v, scale, log_cum=None):
    b, s, h, dk = q.shape
    nb = s // BLOCK_Q
    idx = jnp.arange(nb)
    qb = q.reshape(b, nb, BLOCK_Q, h, dk).transpose(1, 0, 2, 3, 4)
    key_pos = jnp.arange(s)
    if log_cum is not None:
        f_keys = log_cum.transpose(0, 2, 1)
        fb = log_cum.reshape(b, nb, BLOCK_Q, h).transpose(1, 0, 2, 3)
        xs = (idx, qb, fb)
    else:
        xs = (idx, qb)

    def one_block(args):
        i, qi = args[0], args[1]
        logits = jnp.einsum('bqhd,bkhd->bhqk', qi, k,
                            preferred_element_type=jnp.float32) * scale
        if log_cum is not None:
            fi = args[2].transpose(0, 2, 1)
            logits = logits + (fi[..., :, None] - f_keys[:, :, None, :])
        q_pos = i * BLOCK_Q + jnp.arange(BLOCK_Q)
        mask = key_pos[None, :] <= q_pos[:, None]
        logits = jnp.where(mask[None, None], logits, -jnp.inf)
        p = jax.nn.softmax(logits, axis=-1)
        return jnp.einsum('bhqk,bkhd->bqhd', p.astype(v.dtype), v)

    out = lax.map(one_block, xs)
    return out.transpose(1, 0, 2, 3, 4).reshape(b, s, h, v.shape[-1])


def hybrid_mixer(h, positions, w_in, q_norm_g, w_uq, kv_norm_g, w_ukv, b_forget,
                 w_o_mla, w_o_fox, w_out):
    b, s, _ = h.shape
    proj = h @ w_in
    cq, ckv, k_rope, fq, fk, fv, f_logit, g_mla, g_fox = jnp.split(proj, IN_OFFSETS, axis=-1)

    q = (rmsnorm(cq, q_norm_g) @ w_uq).reshape(b, s, MLA_HEADS, MLA_NOPE + MLA_ROPE)
    q_nope, q_rope = q[..., :MLA_NOPE], q[..., MLA_NOPE:]
    kv = (rmsnorm(ckv, kv_norm_g) @ w_ukv).reshape(b, s, MLA_HEADS, MLA_NOPE + MLA_V)
    k_nope, v_mla = kv[..., :MLA_NOPE], kv[..., MLA_NOPE:]
    q_rope = rope(q_rope, positions)
    k_rope = rope(k_rope[:, :, None, :], positions)
    q_mla = jnp.concatenate([q_nope, q_rope], axis=-1)
    k_mla = jnp.concatenate(
        [k_nope, jnp.broadcast_to(k_rope, (b, s, MLA_HEADS, MLA_ROPE))], axis=-1)
    o_mla = causal_block_attention(q_mla, k_mla, v_mla, MLA_SCALE).reshape(b, s, MLA_HEADS * MLA_V)

    log_f = jax.nn.log_sigmoid(f_logit.astype(jnp.float32) + b_forget.astype(jnp.float32))
    f_cum = jnp.cumsum(log_f, axis=1)
    o_fox = causal_block_attention(
        fq.reshape(b, s, FOX_HEADS, FOX_DIM), fk.reshape(b, s, FOX_HEADS, FOX_DIM),
        fv.reshape(b, s, FOX_HEADS, FOX_DIM), FOX_SCALE, f_cum).reshape(b, s, FOX_HEADS * FOX_DIM)

    y = jax.nn.sigmoid(g_mla) * (o_mla @ w_o_mla) + jax.nn.sigmoid(g_fox) * (o_fox @ w_o_fox)
    return y @ w_out


def conv_ffn(h, w_up, conv_w, conv_b, w_down):
    s = h.shape[1]
    u = h @ w_up
    up = jnp.pad(u, ((0, 0), (CONV_WIDTH - 1, 0), (0, 0)))
    u = conv_b + sum(conv_w[j] * up[:, j:j + s] for j in range(CONV_WIDTH))
    gate, val = u[..., :D_FF], u[..., D_FF:]
    return (jax.nn.silu(gate) * val) @ w_down


def modulate(hn, shift, scale):
    return hn * (1.0 + scale[:, None, :]) + shift[:, None, :]


def setup_inputs(seed: int = 0) -> dict:
    key = jax.random.key(seed)
    ks = jax.random.split(key, 24)
    nrm = lambda k, shape, fan: jax.random.normal(k, shape, jnp.float32) * (fan ** -0.5)
    L = DEPTH
    x = jax.random.normal(ks[0], (BATCH, SEQ, D_MODEL), jnp.float32)
    c = jax.random.normal(ks[1], (BATCH, D_MODEL), jnp.float32)
    offsets = jax.random.randint(ks[2], (BATCH, 1), 0, 4096, dtype=jnp.int32)
    positions = offsets + jnp.arange(SEQ, dtype=jnp.int32)[None, :]
    return {
        "x": x,
        "c": c,
        "positions": positions,
        "w_ada": 0.5 * nrm(ks[3], (L, D_MODEL, N_ADA * D_MODEL), D_MODEL),
        "b_ada": 0.01 * jax.random.normal(ks[4], (L, N_ADA * D_MODEL), jnp.float32),
        "norm_mix_g": 1.0 + 0.1 * jax.random.normal(ks[5], (L, D_MODEL), jnp.float32),
        "w_in": nrm(ks[6], (L, D_MODEL, D_IN), D_MODEL),
        "q_norm_g": 1.0 + 0.1 * jax.random.normal(ks[7], (L, MLA_Q_RANK), jnp.float32),
        "w_uq": nrm(ks[8], (L, MLA_Q_RANK, MLA_HEADS * (MLA_NOPE + MLA_ROPE)), MLA_Q_RANK),
        "kv_norm_g": 1.0 + 0.1 * jax.random.normal(ks[9], (L, MLA_KV_RANK), jnp.float32),
        "w_ukv": nrm(ks[10], (L, MLA_KV_RANK, MLA_HEADS * (MLA_NOPE + MLA_V)), MLA_KV_RANK),
        "b_forget": jax.random.uniform(ks[11], (L, FOX_HEADS), jnp.float32, 1.0, 6.0),
        "w_o_mla": nrm(ks[12], (L, MLA_HEADS * MLA_V, D_MODEL), MLA_HEADS * MLA_V),
        "w_o_fox": nrm(ks[13], (L, FOX_HEADS * FOX_DIM, D_MODEL), FOX_HEADS * FOX_DIM),
        "w_out": nrm(ks[14], (L, D_MODEL, D_MODEL), D_MODEL),
        "norm_ffn_g": 1.0 + 0.1 * jax.random.normal(ks[15], (L, D_MODEL), jnp.float32),
        "w_up": nrm(ks[16], (L, D_MODEL, 2 * D_FF), D_MODEL),
        "conv_w": nrm(ks[17], (L, CONV_WIDTH, 2 * D_FF), CONV_WIDTH),
        "conv_b": 0.01 * jax.random.normal(ks[18], (L, 2 * D_FF), jnp.float32),
        "w_down": nrm(ks[19], (L, D_FF, D_MODEL), D_FF),
        "norm_final_g": 1.0 + 0.1 * jax.random.normal(ks[20], (D_MODEL,), jnp.float32),
    }


def reference(x, c, positions, w_ada, b_ada, norm_mix_g, w_in, q_norm_g, w_uq, kv_norm_g,
              w_ukv, b_forget, w_o_mla, w_o_fox, w_out, norm_ffn_g, w_up, conv_w, conv_b,
              w_down, norm_final_g):
    c_act = jax.nn.silu(c)
    for l in range(DEPTH):
        ada = c_act @ w_ada[l] + b_ada[l]
        sh_m, sc_m, g_m, sh_f, sc_f, g_f = jnp.split(ada, N_ADA, axis=-1)
        h = modulate(rmsnorm(x, norm_mix_g[l]), sh_m, sc_m)
        mix = hybrid_mixer(h, positions, w_in[l], q_norm_g[l], w_uq[l], kv_norm_g[l], w_ukv[l],
                           b_forget[l], w_o_mla[l], w_o_fox[l], w_out[l])
        x = x + g_m[:, None, :] * mix
        h = modulate(rmsnorm(x, norm_ffn_g[l]), sh_f, sc_f)
        x = x + g_f[:, None, :] * conv_ffn(h, w_up[l], conv_w[l], conv_b[l], w_down[l])
    return rmsnorm(x, norm_final_g)
```

```cpp
#include <hip/hip_runtime.h>
#include <hip/hip_cooperative_groups.h>
#include <cstdio>
#include <cstdint>
#include <cmath>
namespace cg = cooperative_groups;
namespace pg8 {
#define PG8_LAS __attribute__((address_space(3)))
typedef unsigned short bf16_t;
typedef short bf16x8 __attribute__((ext_vector_type(8)));
typedef float f32x4 __attribute__((ext_vector_type(4)));
typedef unsigned u32x4 __attribute__((ext_vector_type(4)));
constexpr int BM = 256, BK = 64, HALF = 128, HTB = HALF * BK * 2  , STAGE_BYTES = 8 * HTB, NXCD = 8, WGM = 8;

__host__ __device__ __forceinline__ int lds_byte(int r, int c) { const int st = (r >> 4) * 2 + (c >> 5), rr = r & 15, cc = c & 31, ob = rr * 64 + cc * 2; return st * 1024 + (ob ^ (((ob >> 9) & 1) << 5)); }
__host__ __device__ __forceinline__ void stage_rc(int b, int& R, int& C) { const int st = b / 1024, sb = b % 1024, swz = sb ^ (((sb >> 9) & 1) << 5); R = (st >> 1) * 16 + swz / 64; C = (st & 1) * 32 + (swz % 64) / 2; }
__host__ __device__ __forceinline__ int perm32(int rho) { const int n = rho >> 4, i = rho & 15; return 8 * (i >> 2) + 4 * n + (i & 3); }

struct Unit { int pm, pn; };
struct Gemm { const bf16_t* A; const bf16_t* Bt; int M, N, K; };

struct StaticOrder {
    int nM, nN, nwg, G, c, base = 0, single = 0;
    __host__ __device__ void init(int M, int N, int G_, int c_) { nM = M / BM; nN = N / BM; nwg = nM * nN; G = G_; c = c_; }
    __host__ __device__ bool next(int i, Unit& u) const {
        if (single && i > 0) return false;
        const long L = (long)(i + base) * G + c; if (L >= nwg) return false;
        int wgid = (int)L; { const int q = nwg / NXCD, r = nwg % NXCD, xcd = wgid % NXCD, off = wgid / NXCD; wgid = (xcd < r ? xcd * (q + 1) : r * (q + 1) + (xcd - r) * q) + off; }
        const int nig = WGM * nN, gid = wgid / nig, fm = gid * WGM, gsz = (nM - fm) < WGM ? (nM - fm) : WGM;
        u.pm = fm + ((wgid % nig) % gsz); u.pn = (wgid % nig) / gsz; return true;
    }
    __device__ __forceinline__ void a_ready(const Unit&) const {}
    __device__ __forceinline__ void done(const Unit&) const {}
};

__device__ __forceinline__ unsigned cvt_pk_bf16(float lo, float hi) { unsigned r; asm volatile("v_cvt_pk_bf16_f32 %0, %1, %2" : "=v"(r) : "v"(lo), "v"(hi)); return r; }
typedef float f32x2 __attribute__((ext_vector_type(2)));
template <class Epi, class Sched, bool ALIGN_EPI = false, bool SP2 = false>
__device__ __forceinline__ void gemm_phase(PG8_LAS unsigned char* lds, const Gemm g, const Sched& S, const Epi& E) {
    int tid_ = threadIdx.x; asm volatile("" : "+v"(tid_));
    const int tid = tid_, wid = __builtin_amdgcn_readfirstlane(tid >> 6), lane = tid & 63, wr = wid >> 2, wc = wid & 3, fr = lane & 15, fq = lane >> 4;
    int K_ = g.K; asm volatile("" : "+s"(K_));
    const int K = K_, nt = K / BK;
    unsigned voffA[2], voffB[2];
#pragma unroll
    for (int i = 0; i < 2; ++i) { int R, C; stage_rc(tid * 16 + i * 8192, R, C); const int Rb = Epi::PERM ? ((R & ~31) + perm32(R & 31)) : R;
        voffA[i] = (unsigned)(R * K + C) * 2u; voffB[i] = (unsigned)(Rb * K + C) * 2u; }
    const size_t kstep = (size_t)(BK * 2);
    const size_t hstep = (size_t)HALF * K * 2;
    const size_t tstep = 2 * hstep;
    const unsigned ldsw = (unsigned)wid * 1024u;
    const int aoff = lds_byte(wr * 64 + fr, fq * 8), boff = lds_byte(wc * 32 + fr, fq * 8);
#define PG8_SA(b, h) (((b) * 2 + (h)) * HTB)
#define PG8_SB(b, h) ((4 + (b) * 2 + (h)) * HTB)
#define PG8_STAGE(bufoff, gbase, voff) do { _Pragma("unroll") for (int _i = 0; _i < 2; ++_i) \
        __builtin_amdgcn_global_load_lds((const unsigned*)((const char*)(gbase) + (voff)[_i]), (PG8_LAS unsigned*)(lds + (bufoff) + ldsw + _i * 8192), 16, 0, 0); } while (0)
#define PG8_LDA(dst, b, h) do { _Pragma("unroll") for (int m = 0; m < 4; ++m) _Pragma("unroll") for (int k = 0; k < 2; ++k) dst[m][k] = *(const PG8_LAS bf16x8*)(lds + PG8_SA(b, h) + aoff + m * 2048 + k * 1024); } while (0)
#define PG8_LDB(dst, b, h) do { _Pragma("unroll") for (int n = 0; n < 2; ++n) _Pragma("unroll") for (int k = 0; k < 2; ++k) dst[n][k] = *(const PG8_LAS bf16x8*)(lds + PG8_SB(b, h) + boff + n * 2048 + k * 1024); } while (0)
#define PG8_MMA(ai, bj, At, Bt) do { __builtin_amdgcn_s_setprio(1); _Pragma("unroll") for (int m = 0; m < 4; ++m) _Pragma("unroll") for (int n = 0; n < 2; ++n) _Pragma("unroll") for (int k = 0; k < 2; ++k) \
        acc[ai][bj][m][n] = __builtin_amdgcn_mfma_f32_16x16x32_bf16(Bt[n][k], At[m][k], acc[ai][bj][m][n], 0, 0, 0); __builtin_amdgcn_s_setprio(0); } while (0)
#define PG8_WAIT_V(n) asm volatile("s_waitcnt vmcnt(" #n ")" ::: "memory")
#define PG8_WAIT_L(n) asm volatile("s_waitcnt lgkmcnt(" #n ")" ::: "memory")
#define PG8_BAR __builtin_amdgcn_s_barrier()
#define PG8_SCHED __builtin_amdgcn_sched_barrier(0)
    Unit cur, nxt; int ui = 0;
    if (!S.next(0, cur)) return;
    f32x4 acc[2][2][4][2];
#pragma unroll
    for (int a = 0; a < 2; ++a)
#pragma unroll
        for (int b = 0; b < 2; ++b)
#pragma unroll
            for (int m = 0; m < 4; ++m)
#pragma unroll
                for (int n = 0; n < 2; ++n) acc[a][b][m][n] = (f32x4){0.f, 0.f, 0.f, 0.f};
    bf16x8 At[4][2], B0[2][2], B1[2][2];
    const char* cA = (const char*)g.A + (size_t)cur.pm * tstep; const char* cB = (const char*)g.Bt + (size_t)cur.pn * tstep;
    S.a_ready(cur);
    if constexpr (SP2) {
        PG8_STAGE(PG8_SB(0, 0), cB, voffB); PG8_STAGE(PG8_SB(0, 1), cB + hstep, voffB); PG8_STAGE(PG8_SA(0, 0), cA, voffA); PG8_STAGE(PG8_SA(0, 1), cA + hstep, voffA);
        if (wr == 1) PG8_BAR;
        PG8_WAIT_V(2); PG8_BAR;
        PG8_STAGE(PG8_SB(1, 0), cB + kstep, voffB); PG8_STAGE(PG8_SA(1, 0), cA + kstep, voffA); PG8_STAGE(PG8_SB(1, 1), cB + hstep + kstep, voffB);
        PG8_WAIT_V(6); PG8_BAR;
    } else {
        PG8_STAGE(PG8_SB(0, 0), cB, voffB); PG8_STAGE(PG8_SA(0, 0), cA, voffA); PG8_STAGE(PG8_SB(0, 1), cB + hstep, voffB); PG8_STAGE(PG8_SA(0, 1), cA + hstep, voffA);
        if (wr == 1) PG8_BAR;
        PG8_WAIT_V(4); PG8_BAR;
        PG8_STAGE(PG8_SB(1, 0), cB + kstep, voffB); PG8_STAGE(PG8_SA(1, 0), cA + kstep, voffA); PG8_STAGE(PG8_SB(1, 1), cB + hstep + kstep, voffB);
        PG8_WAIT_V(6); PG8_BAR;
    }
    for (;;) {
        const bool has_next = S.next(ui + 1, nxt);
        const char* nA = has_next ? (const char*)g.A + (size_t)nxt.pm * tstep : cA; const char* nB = has_next ? (const char*)g.Bt + (size_t)nxt.pn * tstep : cB;
        for (int t = 0; t < nt; t += 2) {
            const bool last = (t == nt - 2);
            const char* a1 = cA + (size_t)(t + 1) * kstep;
            const char* a2 = last ? nA : cA + (size_t)(t + 2) * kstep; const char* b2 = last ? nB : cB + (size_t)(t + 2) * kstep;
            const char* a3 = a2 + kstep; const char* b3 = b2 + kstep;
            if (last && has_next) S.a_ready(nxt);
            if constexpr (SP2) {
            PG8_LDB(B0, 0, 0); PG8_LDB(B1, 0, 1); PG8_SCHED; PG8_LDA(At, 0, 0); PG8_STAGE(PG8_SA(1, 1), a1 + hstep, voffA);
            PG8_WAIT_V(8); PG8_WAIT_L(0); PG8_BAR; PG8_MMA(0, 0, At, B0); PG8_MMA(0, 1, At, B1); PG8_BAR; PG8_SCHED;
            PG8_LDA(At, 0, 1); PG8_STAGE(PG8_SB(0, 0), b2, voffB); PG8_STAGE(PG8_SB(0, 1), b2 + hstep, voffB); PG8_STAGE(PG8_SA(0, 0), a2, voffA);
            PG8_WAIT_V(8); PG8_WAIT_L(0); PG8_BAR; PG8_MMA(1, 0, At, B0); PG8_MMA(1, 1, At, B1); PG8_BAR; PG8_SCHED;
            PG8_LDB(B0, 1, 0); PG8_LDB(B1, 1, 1); PG8_SCHED; PG8_LDA(At, 1, 0); PG8_STAGE(PG8_SA(0, 1), a2 + hstep, voffA);
            PG8_WAIT_V(8); PG8_WAIT_L(0); PG8_BAR; PG8_MMA(0, 0, At, B0); PG8_MMA(0, 1, At, B1); PG8_BAR; PG8_SCHED;
            PG8_LDA(At, 1, 1); PG8_STAGE(PG8_SB(1, 0), b3, voffB); PG8_STAGE(PG8_SB(1, 1), b3 + hstep, voffB); PG8_STAGE(PG8_SA(1, 0), a3, voffA);
            PG8_WAIT_V(8); PG8_WAIT_L(0); PG8_BAR; PG8_MMA(1, 0, At, B0); PG8_MMA(1, 1, At, B1); PG8_BAR; PG8_SCHED;
            } else {
            PG8_LDB(B0, 0, 0); PG8_SCHED; PG8_LDA(At, 0, 0); PG8_STAGE(PG8_SA(1, 1), a1 + hstep, voffA);
            PG8_WAIT_L(8); PG8_BAR; PG8_WAIT_L(0); PG8_MMA(0, 0, At, B0); PG8_BAR; PG8_SCHED;
            PG8_LDB(B1, 0, 1); PG8_STAGE(PG8_SB(0, 0), b2, voffB);
            PG8_BAR; PG8_WAIT_L(0); PG8_MMA(0, 1, At, B1); PG8_BAR;
            PG8_LDA(At, 0, 1); PG8_STAGE(PG8_SA(0, 0), a2, voffA);
            PG8_BAR; PG8_WAIT_L(0); PG8_MMA(1, 0, At, B0); PG8_BAR; PG8_SCHED;
            PG8_STAGE(PG8_SB(0, 1), b2 + hstep, voffB);
            PG8_WAIT_V(6); PG8_BAR; PG8_MMA(1, 1, At, B1); PG8_BAR;
            PG8_LDB(B0, 1, 0); PG8_SCHED; PG8_LDA(At, 1, 0); PG8_STAGE(PG8_SA(0, 1), a2 + hstep, voffA);
            PG8_WAIT_L(8); PG8_BAR; PG8_WAIT_L(0); PG8_MMA(0, 0, At, B0); PG8_BAR; PG8_SCHED;
            PG8_LDB(B1, 1, 1); PG8_STAGE(PG8_SB(1, 0), b3, voffB);
            PG8_BAR; PG8_WAIT_L(0); PG8_MMA(0, 1, At, B1); PG8_BAR;
            PG8_LDA(At, 1, 1); PG8_STAGE(PG8_SA(1, 0), a3, voffA);
            PG8_BAR; PG8_WAIT_L(0); PG8_MMA(1, 0, At, B0); PG8_BAR; PG8_SCHED;
            PG8_STAGE(PG8_SB(1, 1), b3 + hstep, voffB);
            PG8_WAIT_V(6); PG8_BAR; PG8_MMA(1, 1, At, B1); PG8_BAR;
            }
        }
        if constexpr (ALIGN_EPI) { if (wr == 0) PG8_BAR; }
        if constexpr (!Epi::AFTER_DRAIN) { E(acc, cur, wr, wc, fr, fq); S.done(cur); }
        if (!has_next) break;
#pragma unroll
        for (int a = 0; a < 2; ++a)
#pragma unroll
            for (int b = 0; b < 2; ++b)
#pragma unroll
                for (int m = 0; m < 4; ++m)
#pragma unroll
                    for (int n = 0; n < 2; ++n) acc[a][b][m][n] = (f32x4){0.f, 0.f, 0.f, 0.f};
        cur = nxt; cA = nA; cB = nB; ++ui;
        if constexpr (ALIGN_EPI) { if (wr == 1) PG8_BAR; }
    }
    PG8_WAIT_V(0);
    if constexpr (!ALIGN_EPI) { if (wr == 0) PG8_BAR; }
    PG8_BAR;
    if constexpr (Epi::AFTER_DRAIN) { E.fused(acc, cur, wr, wc, fr, fq, lds, wid, lane); S.done(cur); }
#undef PG8_SA
#undef PG8_SB
#undef PG8_STAGE
#undef PG8_LDA
#undef PG8_LDB
#undef PG8_MMA
#undef PG8_WAIT_V
#undef PG8_WAIT_L
#undef PG8_BAR
#undef PG8_SCHED
}
}
#define LAS __attribute__((address_space(3)))
using pg8::bf16_t; using pg8::bf16x8; using pg8::f32x4; using pg8::u32x4; using pg8::Unit;
typedef float f32x2_t __attribute__((ext_vector_type(2))); typedef __bf16 bf16x2_t __attribute__((ext_vector_type(2)));
__device__ __forceinline__ unsigned cvt_pk_bf16(float lo, float hi) { f32x2_t v = {lo, hi}; bf16x2_t b = __builtin_convertvector(v, bf16x2_t); return __builtin_bit_cast(unsigned, b); }
typedef float f32x16 __attribute__((ext_vector_type(16)));
typedef unsigned u32x2 __attribute__((ext_vector_type(2)));

constexpr int NWAVES = 8, NTHR = 512;
constexpr int BATCH = 2, SEQ = 8192, T = BATCH * SEQ, D = 1024;
constexpr int DIN = 4264, DINP = 4352, NPROJ = 3840;
constexpr int QR = 384, KVR = 256, DFF = 2816, NUP = 5632;
constexpr float EPS = 1e-6f;
constexpr float LOG2E = 1.4426950408889634f;
constexpr float MLA_C = 0.10206207261596577f * LOG2E;
constexpr float FOX_C = 0.125f * LOG2E;
constexpr size_t MiB = 1u << 20;
constexpr size_t WS_WIN = 0, WS_WUQ = 9 * MiB, WS_WUKV = 10 * MiB, WS_WOM = 11 * MiB, WS_WOF = 12 * MiB, WS_WOUT = 13 * MiB, WS_WUP = 15 * MiB, WS_WDN = 26 * MiB;
constexpr size_t WS_HA = 32 * MiB;
constexpr size_t WS_CQ = 64 * MiB, WS_CKV = 76 * MiB, WS_KR = 84 * MiB;
constexpr size_t WS_SMALL = 85 * MiB;
constexpr size_t WS_ADA = WS_SMALL, WS_SSQ = WS_SMALL + 65536, WS_SSK = WS_SMALL + 2 * 65536, ZERO_OFF = WS_SSQ, ZERO_BYTES = 2 * 65536;
constexpr size_t WS_CS = 86 * MiB;
constexpr size_t WS_LF = 88 * MiB;
constexpr size_t WS_FB = 89 * MiB;
constexpr size_t WS_FQ = 96 * MiB, WS_FK = 112 * MiB, WS_FVT = 128 * MiB, WS_GM = 144 * MiB, WS_GF = 176 * MiB;
constexpr size_t WS_KN = 208 * MiB, WS_VMT = 224 * MiB, WS_OM = 240 * MiB, WS_OF = 64 * MiB;
constexpr size_t WS_Q = WS_HA, WS_T1 = WS_HA, WS_H2 = WS_HA, WS_Y = 96 * MiB, WS_ACT = 96 * MiB, WS_HALO = 184 * MiB, WS_PART = 195 * MiB;
constexpr int LDS_BYTES = 135168;

__device__ const double INVF[16] = {1.0, 0.5623413251903491, 0.31622776601683794, 0.1778279410038923, 0.1, 0.05623413251903491, 0.03162277660168379, 0.01778279410038923, 0.01, 0.005623413251903491, 0.0031622776601683794, 0.0017782794100389228, 0.001, 0.0005623413251903491, 0.00031622776601683794, 0.00017782794100389227};

__device__ __forceinline__ float bf2f(unsigned short b) { return __builtin_bit_cast(float, (unsigned)b << 16); }
__device__ __forceinline__ float bflo(unsigned w) { return __builtin_bit_cast(float, w << 16); }
__device__ __forceinline__ float bfhi(unsigned w) { return __builtin_bit_cast(float, w & 0xffff0000u); }
__device__ __forceinline__ unsigned short f2bf(float f) { return (unsigned short)(cvt_pk_bf16(f, 0.f) & 0xffffu); }
__device__ __forceinline__ u32x2 pack4(f32x4 v) { u32x2 w; w.x = cvt_pk_bf16(v[0], v[1]); w.y = cvt_pk_bf16(v[2], v[3]); return w; }
__device__ __forceinline__ float wave_sum(float v) {
#pragma unroll
    for (int o = 1; o < 64; o <<= 1) v += __shfl_xor(v, o);
    return v;
}
__device__ __forceinline__ float sigmoidf_(float x) { return __builtin_amdgcn_rcpf(1.0f + __expf(-x)); }
__device__ __forceinline__ float siluf_(float x) { return x * sigmoidf_(x); }

typedef const f32x4 (&AccRef)[2][2][4][2];

template <int BJ0, int BJ1, bool SSQ, bool RSC>
__device__ __forceinline__ void epi_store(AccRef acc, int row0, bf16_t* dst, int ld, int col0, float scale, float* ssq, const float* rss, float invk, int fq) {
#pragma unroll
    for (int ai = 0; ai < 2; ++ai)
#pragma unroll
        for (int m = 0; m < 4; ++m) {
            const int r = row0 + 128 * ai + 16 * m; float s = 0.f, sc = scale;
            if (RSC) sc *= __builtin_amdgcn_rsqf(rss[r] * invk + EPS);
#pragma unroll
            for (int bj = BJ0; bj < BJ1; ++bj)
#pragma unroll
                for (int n = 0; n < 2; ++n) { const f32x4 v = acc[ai][bj][m][n];
                    if (SSQ) s += (v[0] * v[0] + v[1] * v[1]) + (v[2] * v[2] + v[3] * v[3]);
                    *(u32x2*)(dst + (size_t)r * ld + col0 + (bj - BJ0) * 128 + 16 * n) = pack4(v * sc); }
            if (SSQ) { s += __shfl_xor(s, 16); s += __shfl_xor(s, 32); if (fq == 0) atomicAdd(ssq + r, s); }
        }
}

struct EpiProj {
    static constexpr bool PERM = false, AFTER_DRAIN = false;
    bf16_t *CQ, *CKV, *KR, *FQ, *FK, *GM, *GF; float *LF, *SSQ, *SSK; const float *CS, *bforget;
    __device__ __forceinline__ void operator()(AccRef acc, const Unit& u, int wr, int wc, int fr_, int fq_) const {
        int ln_ = threadIdx.x & 63; asm volatile("" : "+v"(ln_)); const int fr = ln_ & 15, fq = ln_ >> 4; (void)fr_; (void)fq_;
        const int pn = u.pn, row0 = u.pm * 256 + wr * 64 + fr, cw = wc * 32 + 4 * fq;
        if (pn == 0) { epi_store<0, 2, true, false>(acc, row0, CQ, QR, cw, 1.f, SSQ, nullptr, 0.f, fq); }
        else if (pn == 1) {
            epi_store<0, 1, true, false>(acc, row0, CQ, QR, 256 + cw, 1.f, SSQ, nullptr, 0.f, fq);
            if (wc == 0) {
#pragma unroll
                for (int ai = 0; ai < 2; ++ai)
#pragma unroll
                    for (int m = 0; m < 4; ++m) { const int r = row0 + 128 * ai + 16 * m;
                        const f32x4 c = *(const f32x4*)(CS + (size_t)r * 16 + 4 * fq), s = *(const f32x4*)(CS + (size_t)T * 16 + (size_t)r * 16 + 4 * fq);
                        const f32x4 x1 = acc[ai][1][m][0], x2 = acc[ai][1][m][1];
                        *(u32x2*)(KR + (size_t)r * 32 + 4 * fq) = pack4(x1 * c - x2 * s);
                        *(u32x2*)(KR + (size_t)r * 32 + 16 + 4 * fq) = pack4(x2 * c + x1 * s); }
            } else if (wc == 1) {
                if (fq < 2) {
                    const f32x4 bfg = *(const f32x4*)(bforget + 4 * fq);
#pragma unroll
                    for (int ai = 0; ai < 2; ++ai)
#pragma unroll
                        for (int m = 0; m < 4; ++m) { const int r = row0 + 128 * ai + 16 * m; const f32x4 z = acc[ai][1][m][0] + bfg; f32x4 o;
#pragma unroll
                            for (int j = 0; j < 4; ++j) o[j] = fminf(z[j], 0.f) - log1pf(expf(-fabsf(z[j])));
                            *(f32x4*)(LF + (size_t)r * 8 + 4 * fq) = o; }
                }
            }
        }
        else if (pn == 2) { epi_store<0, 2, true, false>(acc, row0, CKV, KVR, cw, 1.f, SSK, nullptr, 0.f, fq); }
        else if (pn <= 4) { epi_store<0, 2, false, false>(acc, row0, FQ, 512, (pn - 3) * 256 + cw, FOX_C, nullptr, nullptr, 0.f, fq); }
        else if (pn <= 6) { epi_store<0, 2, false, false>(acc, row0, FK, 512, (pn - 5) * 256 + cw, 1.f, nullptr, nullptr, 0.f, fq); }
        else {
            bf16_t* G = pn <= 10 ? GM : GF; const int cb = ((pn - 7) & 3) * 256 + cw;
#pragma unroll
            for (int ai = 0; ai < 2; ++ai)
#pragma unroll
                for (int m = 0; m < 4; ++m) { const int r = row0 + 128 * ai + 16 * m;
#pragma unroll
                    for (int bj = 0; bj < 2; ++bj)
#pragma unroll
                        for (int n = 0; n < 2; ++n) { const f32x4 v = acc[ai][bj][m][n]; f32x4 o;
#pragma unroll
                            for (int j = 0; j < 4; ++j) o[j] = sigmoidf_(v[j]);
                            *(u32x2*)(G + (size_t)r * D + cb + bj * 128 + 16 * n) = pack4(o); } }
        }
    }
};

struct EpiVt {
    static constexpr bool PERM = false, AFTER_DRAIN = false;
    bf16_t* dst; const float* ss; float invk;
    __device__ __forceinline__ void operator()(AccRef acc, const Unit& u, int wr, int wc, int fr_, int fq_) const {
        int ln_ = threadIdx.x & 63; asm volatile("" : "+v"(ln_)); const int fr = ln_ & 15, fq = ln_ >> 4; (void)fr_; (void)fq_;
        const int row0 = u.pm * 256 + wr * 64 + fr, c0 = u.pn * 256 + wc * 32 + 4 * fq;
        f32x4 sc[2][2];
#pragma unroll
        for (int bj = 0; bj < 2; ++bj)
#pragma unroll
            for (int n = 0; n < 2; ++n) { sc[bj][n] = (f32x4){1.f, 1.f, 1.f, 1.f};
                if (ss) { const f32x4 q = *(const f32x4*)(ss + c0 + bj * 128 + 16 * n);
#pragma unroll
                    for (int j = 0; j < 4; ++j) sc[bj][n][j] = __builtin_amdgcn_rsqf(q[j] * invk + EPS); } }
#pragma unroll
        for (int ai = 0; ai < 2; ++ai)
#pragma unroll
            for (int m = 0; m < 4; ++m) { const int r = row0 + 128 * ai + 16 * m;
#pragma unroll
                for (int bj = 0; bj < 2; ++bj)
#pragma unroll
                    for (int n = 0; n < 2; ++n) *(u32x2*)(dst + (size_t)r * T + c0 + bj * 128 + 16 * n) = pack4(acc[ai][bj][m][n] * sc[bj][n]); }
    }
};

struct EpiQ {
    static constexpr bool PERM = false, AFTER_DRAIN = false;
    bf16_t* Q; const float *SSQ, *CS;
    __device__ __forceinline__ void operator()(AccRef acc, const Unit& u, int wr, int wc, int fr_, int fq_) const {
        int ln_ = threadIdx.x & 63; asm volatile("" : "+v"(ln_)); const int fr = ln_ & 15, fq = ln_ >> 4; (void)fr_; (void)fq_;
        const int row0 = u.pm * 256 + wr * 64 + fr;
#pragma unroll
        for (int bj = 0; bj < 2; ++bj) { const int g32 = 8 * u.pn + 4 * bj + wc; const bool isrope = (g32 % 3) == 2;
            bf16_t* qb = Q + u.pn * 256 + bj * 128 + wc * 32 + 4 * fq;
#pragma unroll
            for (int ai = 0; ai < 2; ++ai)
#pragma unroll
                for (int m = 0; m < 4; ++m) { const int r = row0 + 128 * ai + 16 * m;
                    const float rs = __builtin_amdgcn_rsqf(SSQ[r] * (1.0f / QR) + EPS) * MLA_C;
                    f32x4 v0 = acc[ai][bj][m][0] * rs, v1 = acc[ai][bj][m][1] * rs;
                    if (isrope) { const f32x4 c = *(const f32x4*)(CS + (size_t)r * 16 + 4 * fq), s = *(const f32x4*)(CS + (size_t)T * 16 + (size_t)r * 16 + 4 * fq);
                        const f32x4 o0 = v0 * c - v1 * s, o1 = v1 * c + v0 * s; v0 = o0; v1 = o1; }
                    bf16_t* p = qb + (size_t)r * 768;
                    *(u32x2*)p = pack4(v0); *(u32x2*)(p + 16) = pack4(v1);
                    asm volatile("" ::: "memory"); } }
    }
};

struct EpiKN {
    static constexpr bool PERM = false, AFTER_DRAIN = false;
    bf16_t* KN; const float* SSK;
    __device__ __forceinline__ void operator()(AccRef acc, const Unit& u, int wr, int wc, int fr_, int fq_) const {
        int ln_ = threadIdx.x & 63; asm volatile("" : "+v"(ln_)); const int fr = ln_ & 15, fq = ln_ >> 4; (void)fr_; (void)fq_;
        epi_store<0, 2, false, true>(acc, u.pm * 256 + wr * 64 + fr, KN, 512, u.pn * 256 + wc * 32 + 4 * fq, 1.f, nullptr, SSK, 1.0f / KVR, fq);
    }
};

template <bool SECOND> struct EpiGate {
    static constexpr bool PERM = false, AFTER_DRAIN = false;
    const bf16_t* G; const bf16_t* T1; bf16_t* O;
    __device__ __forceinline__ void operator()(AccRef acc, const Unit& u, int wr, int wc, int fr_, int fq_) const {
        int ln_ = threadIdx.x & 63; asm volatile("" : "+v"(ln_)); const int fr = ln_ & 15, fq = ln_ >> 4; (void)fr_; (void)fq_;
        const int row0 = u.pm * 256 + wr * 64 + fr, c0 = u.pn * 256 + wc * 32 + 4 * fq;
#pragma unroll
        for (int ai = 0; ai < 2; ++ai)
#pragma unroll
            for (int m = 0; m < 4; ++m) { const size_t ro = (size_t)(row0 + 128 * ai + 16 * m) * D + c0;
#pragma unroll
                for (int bj = 0; bj < 2; ++bj)
#pragma unroll
                    for (int n = 0; n < 2; ++n) { const size_t o = ro + bj * 128 + 16 * n; const u32x2 g = *(const u32x2*)(G + o);
                        f32x4 v = acc[ai][bj][m][n] * (f32x4){bflo(g.x), bfhi(g.x), bflo(g.y), bfhi(g.y)};
                        if (SECOND) { const u32x2 t = *(const u32x2*)(T1 + o); v += (f32x4){bflo(t.x), bfhi(t.x), bflo(t.y), bfhi(t.y)}; }
                        *(u32x2*)(O + o) = pack4(v); } }
    }
};

struct EpiRes {
    static constexpr bool PERM = false, AFTER_DRAIN = false;
    const float* base; float* out; const float* gate;
    __device__ __forceinline__ void operator()(AccRef acc, const Unit& u, int wr, int wc, int fr_, int fq_) const {
        int ln_ = threadIdx.x & 63; asm volatile("" : "+v"(ln_)); const int fr = ln_ & 15, fq = ln_ >> 4; (void)fr_; (void)fq_;
        const int row0 = u.pm * 256 + wr * 64 + fr, c0 = u.pn * 256 + wc * 32 + 4 * fq; const float* gp = gate + (u.pm >> 5) * 6144 + c0;
        f32x4 gv[2][2];
#pragma unroll
        for (int bj = 0; bj < 2; ++bj)
#pragma unroll
            for (int n = 0; n < 2; ++n) gv[bj][n] = *(const f32x4*)(gp + bj * 128 + 16 * n);
#pragma unroll
        for (int ai = 0; ai < 2; ++ai)
#pragma unroll
            for (int m = 0; m < 4; ++m) { const size_t ro = (size_t)(row0 + 128 * ai + 16 * m) * D + c0;
#pragma unroll
                for (int bj = 0; bj < 2; ++bj)
#pragma unroll
                    for (int n = 0; n < 2; ++n) { const size_t o = ro + bj * 128 + 16 * n; const f32x4 b = *(const f32x4*)(base + o);
                        *(f32x4*)(out + o) = b + gv[bj][n] * acc[ai][bj][m][n]; }
                asm volatile("" ::: "memory"); }
    }
};

__device__ __forceinline__ f32x4 shfl4(f32x4 v, int src) { f32x4 o;
#pragma unroll
    for (int j = 0; j < 4; ++j) o[j] = __shfl(v[j], src);
    return o; }
struct EpiConv {
    static constexpr bool PERM = false, AFTER_DRAIN = false;
    bf16_t* ACT; float *HALO, *PART; const float *cw, *cb;
    __device__ __forceinline__ void operator()(AccRef acc, const Unit& u, int wr, int wc, int fr_, int fq_) const {
        int ln_ = threadIdx.x & 63; asm volatile("" : "+v"(ln_)); const int fr = ln_ & 15, fq = ln_ >> 4; (void)fr_; (void)fq_;
        const int lane = fq * 16 + fr, s1 = fq * 16 + ((fr + 15) & 15), s2 = fq * 16 + ((fr + 14) & 15);
#pragma unroll
        for (int ai = 0; ai < 2; ++ai) { const int grp = 4 * u.pm + 2 * ai + wr, r0 = 64 * grp + fr;
#pragma unroll
            for (int n = 0; n < 2; ++n) { const int ng = 128 * u.pn + 32 * wc + 16 * n + 4 * fq;
                const f32x4 wg0 = *(const f32x4*)(cw + ng), wg1 = *(const f32x4*)(cw + NUP + ng), wg2 = *(const f32x4*)(cw + 2 * NUP + ng), bg = *(const f32x4*)(cb + ng);
                const f32x4 wv0 = *(const f32x4*)(cw + DFF + ng), wv1 = *(const f32x4*)(cw + NUP + DFF + ng), wv2 = *(const f32x4*)(cw + 2 * NUP + DFF + ng), bv = *(const f32x4*)(cb + DFF + ng);
                f32x4 pg1 = (f32x4){0.f, 0.f, 0.f, 0.f}, pg2 = pg1, pv1 = pg1, pv2 = pg1;
#pragma unroll
                for (int m = 0; m < 4; ++m) { const f32x4 G = acc[ai][0][m][n], V = acc[ai][1][m][n];
                    const f32x4 g1 = shfl4(G, s1), g2 = shfl4(G, s2), v1 = shfl4(V, s1), v2 = shfl4(V, s2);
                    const f32x4 gm1 = fr >= 1 ? g1 : pg1, gm2 = fr >= 2 ? g2 : pg2, vm1 = fr >= 1 ? v1 : pv1, vm2 = fr >= 2 ? v2 : pv2;
                    const f32x4 cg = bg + wg0 * gm2 + wg1 * gm1 + wg2 * G, cv = bv + wv0 * vm2 + wv1 * vm1 + wv2 * V;
                    const int r = r0 + 16 * m;
                    if (m == 0 && fr < 2) { *(f32x4*)(PART + ((size_t)grp * 2 + fr) * NUP + ng) = cg; *(f32x4*)(PART + ((size_t)grp * 2 + fr) * NUP + DFF + ng) = cv; }
                    else { f32x4 a;
#pragma unroll
                        for (int j = 0; j < 4; ++j) a[j] = siluf_(cg[j]) * cv[j];
                        *(u32x2*)(ACT + (size_t)r * DFF + ng) = pack4(a); }
                    if (m == 3 && fr >= 14) { *(f32x4*)(HALO + ((size_t)grp * 2 + (fr - 14)) * NUP + ng) = G; *(f32x4*)(HALO + ((size_t)grp * 2 + (fr - 14)) * NUP + DFF + ng) = V; }
                    pg1 = g1; pg2 = g2; pv1 = v1; pv2 = v2; }
                (void)lane; } }
    }
};

__device__ __forceinline__ int crow(int r, int hi) { return (r & 3) + 8 * (r >> 2) + 4 * hi; }
constexpr int VSTR = 136, ATT_VOFF = 2 * 64 * 208;
template <int NSTEP, int NCH, int KSTR>
__device__ __forceinline__ void attn_unit(LAS unsigned char* lds, int b, int h, int qb, const bf16_t* Qp, int qld, int qcol,
                                          const bf16_t* K1, int k1ld, int k1col, const bf16_t* K2, int k2ld, int k2col, const bf16_t* Vt, int vrow0, bf16_t* O, int ocol) {
    const int tid = threadIdx.x, lane = tid & 63, r32 = lane & 31, hi = lane >> 5, wid = __builtin_amdgcn_readfirstlane(tid >> 6);
    const size_t rowbase = (size_t)b * SEQ;
    const int qrow = 256 * qb + 32 * wid + r32;
    bf16x8 qf[NSTEP];
#pragma unroll
    for (int d0 = 0; d0 < (NSTEP == 6 ? 6 : 4); ++d0) qf[d0] = *(const bf16x8*)(Qp + (rowbase + qrow) * qld + qcol + 16 * d0 + 8 * hi);
    if (NSTEP == 5) { const short one = hi ? (short)0 : (short)0x3F80; qf[NSTEP - 1] = (bf16x8){one, one, one, 0, 0, 0, 0, 0}; }
    const bf16_t* ksrc[2]; int kdst[2]; bool kact[2];
#pragma unroll
    for (int i = 0; i < 2; ++i) { const int idx = tid + 512 * i; kact[i] = idx < 64 * NCH; const int row = idx / NCH, c = idx % NCH;
        ksrc[i] = c < 8 ? K1 + (rowbase + row) * k1ld + k1col + 8 * c : K2 + (rowbase + row) * k2ld + k2col + 8 * (c - 8);
        kdst[i] = row * KSTR + c * 16; }
    const size_t kstep1 = (size_t)64 * k1ld, kstep2 = (size_t)64 * k2ld;
    bool kis1[2];
#pragma unroll
    for (int i = 0; i < 2; ++i) kis1[i] = ((tid + 512 * i) % NCH) < 8;
    const bf16_t* vsrc = Vt + (size_t)(vrow0 + (tid >> 3)) * T + rowbase + 8 * (tid & 7);
    const int vdst = ATT_VOFF + (tid >> 3) * VSTR + (tid & 7) * 16;
    const int NT = 4 * qb + 4;
    u32x4 kreg[2], vreg;
#define ATT_LOAD(t) do { _Pragma("unroll") for (int i = 0; i < 2; ++i) if (kact[i]) kreg[i] = *(const u32x4*)(ksrc[i] + (size_t)(t) * (kis1[i] ? kstep1 : kstep2)); \
        vreg = *(const u32x4*)(vsrc + (size_t)(t) * 64); } while (0)
#define ATT_WRITE(buf) do { _Pragma("unroll") for (int i = 0; i < 2; ++i) if (kact[i]) *(LAS u32x4*)(lds + (buf) * (64 * KSTR) + kdst[i]) = kreg[i]; \
        *(LAS u32x2*)(lds + vdst + (buf) * (64 * VSTR)) = (u32x2){vreg.x, vreg.y}; *(LAS u32x2*)(lds + vdst + (buf) * (64 * VSTR) + 8) = (u32x2){vreg.z, vreg.w}; } while (0)
    ATT_LOAD(0); ATT_WRITE(0);
    __syncthreads();
    f32x16 o0 = {}, o1 = {}; float mrun = -INFINITY, lrun = 0.f;
    const int wq0 = 256 * qb + 32 * wid;
    for (int t = 0; t < NT; ++t) {
        const int buf = t & 1, kv0 = 64 * t;
        if (t + 1 < NT) ATT_LOAD(t + 1);
        if (kv0 <= wq0 + 31) {
            const LAS unsigned char* kb = lds + buf * (64 * KSTR);
            f32x16 p[2];
#pragma unroll
            for (int hh = 0; hh < 2; ++hh) { f32x16 a = {};
#pragma unroll
                for (int d0 = 0; d0 < NSTEP; ++d0) { bf16x8 kf = *(const LAS bf16x8*)(kb + (32 * hh + r32) * KSTR + d0 * 32 + hi * 16);
                    if (NSTEP == 5 && d0 == 4) { if (hi) kf = (bf16x8){0, 0, 0, 0, 0, 0, 0, 0}; }
                    a = __builtin_amdgcn_mfma_f32_32x32x16_bf16(kf, qf[d0], a, 0, 0, 0); }
                p[hh] = a; }
            if (kv0 + 63 > wq0) {
#pragma unroll
                for (int hh = 0; hh < 2; ++hh)
#pragma unroll
                    for (int r = 0; r < 16; ++r) { const int kvg = kv0 + 32 * hh + crow(r, hi); if (kvg > qrow) p[hh][r] = -INFINITY; }
            }
            float mx = fmaxf(p[0][0], p[1][0]);
#pragma unroll
            for (int r = 1; r < 16; ++r) mx = fmaxf(mx, fmaxf(p[0][r], p[1][r]));
            mx = fmaxf(mx, __shfl_xor(mx, 32));
            const float mnew = fmaxf(mrun, mx), alpha = __builtin_amdgcn_exp2f(mrun - mnew); mrun = mnew;
            float rs = 0.f;
#pragma unroll
            for (int hh = 0; hh < 2; ++hh)
#pragma unroll
                for (int r = 0; r < 16; ++r) { const float e = __builtin_amdgcn_exp2f(p[hh][r] - mnew); p[hh][r] = e; rs += e; }
            lrun = lrun * alpha + rs;
#pragma unroll
            for (int r = 0; r < 16; ++r) { o0[r] *= alpha; o1[r] *= alpha; }
            bf16x8 pb[4];
#pragma unroll
            for (int j = 0; j < 4; ++j) { const int hh = j >> 1, rb = 8 * (j & 1);
                const unsigned w0 = cvt_pk_bf16(p[hh][rb + 0], p[hh][rb + 1]), w1 = cvt_pk_bf16(p[hh][rb + 2], p[hh][rb + 3]), w2 = cvt_pk_bf16(p[hh][rb + 4], p[hh][rb + 5]), w3 = cvt_pk_bf16(p[hh][rb + 6], p[hh][rb + 7]);
                pb[j] = __builtin_bit_cast(bf16x8, (u32x4){w0, w1, w2, w3}); }
            const LAS unsigned char* vb = lds + ATT_VOFF + buf * (64 * VSTR) + r32 * VSTR + hi * 8;
#pragma unroll
            for (int j = 0; j < 4; ++j) {
                const u32x2 a0 = *(const LAS u32x2*)(vb + j * 32), a1 = *(const LAS u32x2*)(vb + j * 32 + 16);
                const u32x2 c0 = *(const LAS u32x2*)(vb + 32 * VSTR + j * 32), c1 = *(const LAS u32x2*)(vb + 32 * VSTR + j * 32 + 16);
                o0 = __builtin_amdgcn_mfma_f32_32x32x16_bf16(__builtin_bit_cast(bf16x8, (u32x4){a0.x, a0.y, a1.x, a1.y}), pb[j], o0, 0, 0, 0);
                o1 = __builtin_amdgcn_mfma_f32_32x32x16_bf16(__builtin_bit_cast(bf16x8, (u32x4){c0.x, c0.y, c1.x, c1.y}), pb[j], o1, 0, 0, 0); }
        }
        if (t + 1 < NT) ATT_WRITE(buf ^ 1);
        __syncthreads();
    }
#undef ATT_LOAD
#undef ATT_WRITE
    lrun += __shfl_xor(lrun, 32);
    const float inv = 1.0f / lrun;
    bf16_t* op = O + (rowbase + qrow) * 512 + ocol + 4 * hi;
#pragma unroll
    for (int g = 0; g < 4; ++g) {
        *(u32x2*)(op + 8 * g) = pack4((f32x4){o0[4 * g], o0[4 * g + 1], o0[4 * g + 2], o0[4 * g + 3]} * inv);
        *(u32x2*)(op + 32 + 8 * g) = pack4((f32x4){o1[4 * g], o1[4 * g + 1], o1[4 * g + 2], o1[4 * g + 3]} * inv); }
}

struct Args { const void* in[21]; float* out; unsigned char* ws; int ph_lo, ph_hi; };
constexpr int NPH = 12;

__device__ __forceinline__ void transpose_item(const float* W, int ldw, int k0, int sc0, int nvalid, const float* kscale, bf16_t* WT, int K, int drow0, LAS float* scr, int lane) {
#pragma unroll 8
    for (int i = 0; i < 32; ++i) { const int kk = 2 * i + (lane >> 5), n = lane & 31; float v = 0.f;
        if (n < nvalid) { v = W[(size_t)(k0 + kk) * ldw + sc0 + n]; if (kscale) v *= kscale[k0 + kk]; }
        scr[kk * 33 + n] = v; }
    asm volatile("s_waitcnt lgkmcnt(0)" ::: "memory");
    const int c = lane & 7;
#pragma unroll
    for (int j = 0; j < 4; ++j) { const int n = (lane >> 3) + 8 * j; const LAS float* s = scr + (8 * c) * 33 + n;
        u32x4 o; o.x = cvt_pk_bf16(s[0 * 33], s[1 * 33]); o.y = cvt_pk_bf16(s[2 * 33], s[3 * 33]); o.z = cvt_pk_bf16(s[4 * 33], s[5 * 33]); o.w = cvt_pk_bf16(s[6 * 33], s[7 * 33]);
        *(u32x4*)(WT + (size_t)(drow0 + n) * K + k0 + 8 * c) = o; }
    asm volatile("s_waitcnt lgkmcnt(0)" ::: "memory");
}
__device__ __forceinline__ void win_map(int d0, int& sc0, int& nv) {
    nv = 32;
    if (d0 < 384) sc0 = d0; else if (d0 < 416) sc0 = 640 + (d0 - 384); else if (d0 < 448) { sc0 = 2208; nv = 8; } else if (d0 < 512) { sc0 = 0; nv = 0; }
    else if (d0 < 768) sc0 = 384 + (d0 - 512); else if (d0 < 1280) sc0 = 672 + (d0 - 768); else if (d0 < 1792) sc0 = 1184 + (d0 - 1280);
    else if (d0 < 2816) sc0 = 2216 + (d0 - 1792); else if (d0 < 3840) sc0 = 3240 + (d0 - 2816); else sc0 = 1696 + (d0 - 3840);
}

__device__ __forceinline__ void modnorm_row(const float* xrow, bf16_t* orow, const float* g, const float* sc, const float* sh, int lane) {
    f32x4 v[4]; float s = 0.f;
#pragma unroll
    for (int j = 0; j < 4; ++j) { v[j] = *((const f32x4*)xrow + lane + 64 * j); s += (v[j][0] * v[j][0] + v[j][1] * v[j][1]) + (v[j][2] * v[j][2] + v[j][3] * v[j][3]); }
    const float rstd = __builtin_amdgcn_rsqf(wave_sum(s) * (1.0f / D) + EPS);
#pragma unroll
    for (int j = 0; j < 4; ++j) { const int c = 4 * (lane + 64 * j); const f32x4 gg = *(const f32x4*)(g + c), ss = *(const f32x4*)(sc + c), hh = *(const f32x4*)(sh + c);
        const f32x4 y = (v[j] * rstd * gg) * (ss + 1.0f) + hh; *(u32x2*)(orow + c) = pack4(y); }
}

template <unsigned MASK> __global__ void __launch_bounds__(NTHR, 2) mk_fwd(Args args) {
    extern __shared__ __attribute__((aligned(16))) unsigned char lds_raw[];
    LAS unsigned char* lds = (LAS unsigned char*)lds_raw;
    cg::grid_group grid = cg::this_grid();
    const int tid = threadIdx.x, lane = tid & 63, wave = __builtin_amdgcn_readfirstlane(tid >> 6);
    const int G = gridDim.x, bid = blockIdx.x;
    const int gw = bid * NWAVES + wave, NGW = G * NWAVES;
    unsigned char* ws = args.ws;
    const float* x = (const float*)args.in[0]; const float* cvec = (const float*)args.in[1]; const int* positions = (const int*)args.in[2];
    const float* w_ada = (const float*)args.in[3]; const float* b_ada = (const float*)args.in[4]; const float* norm_mix_g = (const float*)args.in[5];
    const float* w_in = (const float*)args.in[6]; const float* q_norm_g = (const float*)args.in[7]; const float* w_uq = (const float*)args.in[8];
    const float* kv_norm_g = (const float*)args.in[9]; const float* w_ukv = (const float*)args.in[10]; const float* b_forget = (const float*)args.in[11];
    const float* w_o_mla = (const float*)args.in[12]; const float* w_o_fox = (const float*)args.in[13]; const float* w_out = (const float*)args.in[14];
    const float* norm_ffn_g = (const float*)args.in[15]; const float* w_up = (const float*)args.in[16]; const float* conv_w = (const float*)args.in[17];
    const float* conv_b = (const float*)args.in[18]; const float* w_down = (const float*)args.in[19]; const float* norm_final_g = (const float*)args.in[20];
    float* out = args.out;
    bf16_t *Win_t = (bf16_t*)(ws + WS_WIN), *Wuq_t = (bf16_t*)(ws + WS_WUQ), *Wukv_t = (bf16_t*)(ws + WS_WUKV), *Wom_t = (bf16_t*)(ws + WS_WOM), *Wof_t = (bf16_t*)(ws + WS_WOF),
           *Wout_t = (bf16_t*)(ws + WS_WOUT), *Wup_t = (bf16_t*)(ws + WS_WUP), *Wdn_t = (bf16_t*)(ws + WS_WDN);
    bf16_t *HA = (bf16_t*)(ws + WS_HA), *CQ = (bf16_t*)(ws + WS_CQ), *CKV = (bf16_t*)(ws + WS_CKV), *KR = (bf16_t*)(ws + WS_KR), *FB = (bf16_t*)(ws + WS_FB),
           *FQ = (bf16_t*)(ws + WS_FQ), *FK = (bf16_t*)(ws + WS_FK), *FVt = (bf16_t*)(ws + WS_FVT), *GM = (bf16_t*)(ws + WS_GM), *GF = (bf16_t*)(ws + WS_GF),
           *KN = (bf16_t*)(ws + WS_KN), *VMt = (bf16_t*)(ws + WS_VMT), *OM = (bf16_t*)(ws + WS_OM), *OF = (bf16_t*)(ws + WS_OF), *Qb = (bf16_t*)(ws + WS_Q),
           *T1 = (bf16_t*)(ws + WS_T1), *H2 = (bf16_t*)(ws + WS_H2), *Y = (bf16_t*)(ws + WS_Y), *ACT = (bf16_t*)(ws + WS_ACT);
    float *ADA = (float*)(ws + WS_ADA), *SSQ = (float*)(ws + WS_SSQ), *SSK = (float*)(ws + WS_SSK), *CS = (float*)(ws + WS_CS), *LF = (float*)(ws + WS_LF),
          *HALO = (float*)(ws + WS_HALO), *PART = (float*)(ws + WS_PART);
    const int lo = args.ph_lo, hi = args.ph_hi & 0xff, sub = args.ph_hi >> 8;
#define IN(k) (((MASK >> (k)) & 1u) && lo <= (k) && (k) < hi)
#define SEAM(k) do { if (IN(k) && IN((k) + 1)) grid.sync(); } while (0)

    if (IN(0)) {
        LAS float* sl = (LAS float*)lds;
        for (int i = tid; i < 2 * D; i += NTHR) sl[i] = siluf_(cvec[i]);
        __syncthreads();
        for (int cgp = bid; cgp < 192; cgp += G) {
            const int n = cgp * 32 + (lane & 31), kp = lane >> 5; float a0 = 0.f, a1 = 0.f;
#pragma unroll 16
            for (int i = 0; i < 64; ++i) { const int k = 128 * wave + 2 * i + kp; const float w = w_ada[(size_t)k * 6144 + n]; a0 += sl[k] * w; a1 += sl[D + k] * w; }
            a0 += __shfl_xor(a0, 32); a1 += __shfl_xor(a1, 32);
            if (lane < 32) { sl[2048 + (wave * 2 + 0) * 32 + lane] = a0; sl[2048 + (wave * 2 + 1) * 32 + lane] = a1; }
            __syncthreads();
            if (tid < 64) { const int bb = tid >> 5, nn = tid & 31; float s = b_ada[cgp * 32 + nn];
#pragma unroll
                for (int w = 0; w < 8; ++w) s += sl[2048 + (w * 2 + bb) * 32 + nn];
                ADA[bb * 6144 + cgp * 32 + nn] = s; }
            __syncthreads();
        }
        __syncthreads();
        for (int i = bid * NTHR + tid; i < T * 16; i += G * NTHR) { const int row = i >> 4, k = i & 15;
            const double rev = (double)positions[row] * INVF[k] * 0.15915494309189535; const double fr = rev - floor(rev);
            const float a = (float)(fr < 0.5 ? fr : fr - 1.0) * 6.283185307179586f;
            CS[i] = __cosf(a); CS[T * 16 + i] = __sinf(a); }
        LAS float* scr = (LAS float*)(lds + 16384 + wave * 8704);
        constexpr int I_IN = (DINP / 32) * 16, I_UQ = 24 * 6, I_UKV = 32 * 4, I_OM = 32 * 8, I_OUT = 32 * 16, I_UP = (NUP / 32) * 16, I_DN = 32 * 44;
        constexpr int NITEMS = I_IN + I_UQ + I_UKV + 2 * I_OM + I_OUT + I_UP + I_DN;
        for (int it = gw; it < NITEMS; it += NGW) {
            int r = it;
            if (r < I_IN) { const int rb = r % (DINP / 32), kb = r / (DINP / 32); int sc0, nv; win_map(32 * rb, sc0, nv); transpose_item(w_in, DIN, 64 * kb, sc0, nv, nullptr, Win_t, D, 32 * rb, scr, lane); continue; } r -= I_IN;
            if (r < I_UQ) { const int rb = r % 24, kb = r / 24; transpose_item(w_uq, 768, 64 * kb, 32 * rb, 32, q_norm_g, Wuq_t, QR, 32 * rb, scr, lane); continue; } r -= I_UQ;
            if (r < I_UKV) { const int rb = r % 32, kb = r / 32; const int d0 = 32 * rb, dd = d0 & 511, sc0 = (dd >> 6) * 128 + (dd & 63) + (d0 >= 512 ? 64 : 0);
                transpose_item(w_ukv, 1024, 64 * kb, sc0, 32, kv_norm_g, Wukv_t, KVR, d0, scr, lane); continue; } r -= I_UKV;
            if (r < I_OM) { const int rb = r % 32, kb = r / 32; transpose_item(w_o_mla, D, 64 * kb, 32 * rb, 32, nullptr, Wom_t, 512, 32 * rb, scr, lane); continue; } r -= I_OM;
            if (r < I_OM) { const int rb = r % 32, kb = r / 32; transpose_item(w_o_fox, D, 64 * kb, 32 * rb, 32, nullptr, Wof_t, 512, 32 * rb, scr, lane); continue; } r -= I_OM;
            if (r < I_OUT) { const int rb = r % 32, kb = r / 32; transpose_item(w_out, D, 64 * kb, 32 * rb, 32, nullptr, Wout_t, D, 32 * rb, scr, lane); continue; } r -= I_OUT;
            if (r < I_UP) { const int rb = r % (NUP / 32), kb = r / (NUP / 32); const int d0 = 32 * rb, tt = d0 >> 8, rr = d0 & 255, sc0 = rr < 128 ? 128 * tt + rr : DFF + 128 * tt + (rr - 128);
                transpose_item(w_up, NUP, 64 * kb, sc0, 32, nullptr, Wup_t, D, d0, scr, lane); continue; } r -= I_UP;
            { const int rb = r % 32, kb = r / 32; transpose_item(w_down, D, 64 * kb, 32 * rb, 32, nullptr, Wdn_t, DFF, 32 * rb, scr, lane); }
        }
    }
    SEAM(0);
    if (IN(1)) {
        for (int m = gw; m < T; m += NGW) { const float* ad = ADA + (m >> 13) * 6144; modnorm_row(x + (size_t)m * D, HA + (size_t)m * D, norm_mix_g, ad + 1024, ad, lane); }
    }
    SEAM(1);
    if (IN(2)) {
        { pg8::Gemm g{HA, Win_t, T, NPROJ, D}; pg8::StaticOrder S; S.init(T, NPROJ, G, bid);
          EpiProj E{CQ, CKV, KR, FQ, FK, GM, GF, LF, SSQ, SSK, CS, b_forget};
#ifdef SINGLE_UNIT
          S.single = 1;
#pragma unroll 1
          for (int rd = 0; rd * G < S.nwg; ++rd) { S.base = rd; pg8::gemm_phase<EpiProj, pg8::StaticOrder, true, true>(lds, g, S, E); }
#else
          pg8::gemm_phase<EpiProj, pg8::StaticOrder, true, true>(lds, g, S, E);
#endif
        }
#ifndef NO_G2
        { pg8::Gemm g{Win_t + (size_t)NPROJ * D, HA, 512, T, D}; pg8::StaticOrder S; S.init(512, T, G, G - 1 - bid);
          EpiVt E{FVt, nullptr, 0.f};
          pg8::gemm_phase<EpiVt, pg8::StaticOrder, true, true>(lds, g, S, E); }
#endif
    }
    SEAM(2);
    if (IN(3)) {
#ifndef P3_NO_SCAN
        for (int sq = bid; sq < 16; sq += G) {
            const int bb = sq >> 3, hh = sq & 7; LAS double* sd = (LAS double*)lds;
            double v[16]; double run = 0.0;
#pragma unroll
            for (int j = 0; j < 16; ++j) { run += (double)LF[((size_t)bb * SEQ + 16 * tid + j) * 8 + hh]; v[j] = run; }
            sd[tid] = run; __syncthreads();
            if (tid < 64) { double loc[8]; double s = 0.0;
#pragma unroll
                for (int j = 0; j < 8; ++j) { s += sd[tid * 8 + j]; loc[j] = s; }
                double incl = s;
#pragma unroll
                for (int o = 1; o < 64; o <<= 1) { const double up = __shfl_up(incl, o); if (lane >= o) incl += up; }
                const double excl = incl - s;
#pragma unroll
                for (int j = 0; j < 8; ++j) sd[512 + tid * 8 + j] = excl + loc[j]; }
            __syncthreads();
            const double off = tid ? sd[512 + tid - 1] : 0.0;
#pragma unroll
            for (int j = 0; j < 16; ++j) { const double val = -(v[j] + off) * 1.4426950408889634;
                const float f1 = (float)val; const unsigned short b1 = f2bf(f1); const double r1 = val - (double)bf2f(b1);
                const unsigned short b2 = f2bf((float)r1); const double r2 = r1 - (double)bf2f(b2); const unsigned short b3 = f2bf((float)r2);
                *(u32x4*)(FB + (((size_t)bb * SEQ + 16 * tid + j) * 8 + hh) * 8) = (u32x4){(unsigned)b1 | ((unsigned)b2 << 16), (unsigned)b3, 0u, 0u}; }
            __syncthreads();
        }
#endif
#ifndef P3_NO_Q
        { pg8::Gemm g{CQ, Wuq_t, T, 768, QR}; pg8::StaticOrder S; S.init(T, 768, G, bid); EpiQ E{Qb, SSQ, CS};
          pg8::gemm_phase<EpiQ, pg8::StaticOrder, true, true>(lds, g, S, E); }
#endif
#ifndef P3_NO_KN
        { pg8::Gemm g{CKV, Wukv_t, T, 512, KVR}; pg8::StaticOrder S; S.init(T, 512, G, G - 1 - bid); EpiKN E{KN, SSK};
          pg8::gemm_phase<EpiKN, pg8::StaticOrder, true, true>(lds, g, S, E); }
#endif
#ifndef P3_NO_VMT
        { pg8::Gemm g{Wukv_t + (size_t)512 * KVR, CKV, 512, T, KVR}; pg8::StaticOrder S; S.init(512, T, G, (bid + G / 2) % G); EpiVt E{VMt, SSK, 1.0f / KVR};
          pg8::gemm_phase<EpiVt, pg8::StaticOrder, true, true>(lds, g, S, E); }
#endif
    }
    SEAM(3);
    if (IN(4)) {
        for (int pr = bid; pr < 512; pr += G) {
            const int br = pr >> 8, bh = (pr & 255) >> 4, pi = pr & 15, bb = bh >> 3, hh = bh & 7;
#pragma unroll 1
            for (int s = 0; s < 2; ++s) { const int qb = s ? pi : 31 - pi;
                if (br == 0) attn_unit<6, 12, 208>(lds, bb, hh, qb, Qb, 768, hh * 96, KN, 512, hh * 64, KR, 32, 0, VMt, hh * 64, OM, hh * 64);
                else attn_unit<5, 9, 144>(lds, bb, hh, qb, FQ, 512, hh * 64, FK, 512, hh * 64, FB, 64, hh * 8, FVt, hh * 64, OF, hh * 64);
                __syncthreads(); }
        }
    }
    SEAM(4);
    if (IN(5)) {
        if (!(sub & 2)) { pg8::Gemm g{OM, Wom_t, T, D, 512}; pg8::StaticOrder S; S.init(T, D, G, bid); EpiGate<false> E{GM, nullptr, T1};
          pg8::gemm_phase<EpiGate<false>, pg8::StaticOrder, true, true>(lds, g, S, E); }
        if (!(sub & 1)) { pg8::Gemm g{OF, Wof_t, T, D, 512}; pg8::StaticOrder S; S.init(T, D, G, bid);
#ifdef G8_NO_T1
          EpiGate<false> E{GF, nullptr, Y};
          pg8::gemm_phase<EpiGate<false>, pg8::StaticOrder, true, true>(lds, g, S, E); }
#else
          EpiGate<true> E{GF, T1, Y};
          pg8::gemm_phase<EpiGate<true>, pg8::StaticOrder, true, true>(lds, g, S, E); }
#endif
    }
    SEAM(5);
    if (IN(6)) {
        pg8::Gemm g{Y, Wout_t, T, D, D}; pg8::StaticOrder S; S.init(T, D, G, bid); EpiRes E{x, out, ADA + 2048};
        pg8::gemm_phase<EpiRes, pg8::StaticOrder, true, true>(lds, g, S, E);
    }
    SEAM(6);
    if (IN(7)) {
        for (int m = gw; m < T; m += NGW) { const float* ad = ADA + (m >> 13) * 6144; modnorm_row(out + (size_t)m * D, H2 + (size_t)m * D, norm_ffn_g, ad + 4096, ad + 3072, lane); }
    }
    SEAM(7);
    if (IN(8)) {
        pg8::Gemm g{H2, Wup_t, T, NUP, D}; pg8::StaticOrder S; S.init(T, NUP, G, bid); EpiConv E{ACT, HALO, PART, conv_w, conv_b};
        pg8::gemm_phase<EpiConv, pg8::StaticOrder, true, true>(lds, g, S, E);
    }
    SEAM(8);
    if (IN(9)) {
        for (int i = bid * NTHR + tid; i < 256 * 2 * (DFF / 4); i += G * NTHR) {
            const int c4 = i % (DFF / 4), rr = (i / (DFF / 4)) & 1, grp = i / (2 * (DFF / 4)), ng = 4 * c4;
            f32x4 cgv = *(const f32x4*)(PART + ((size_t)grp * 2 + rr) * NUP + ng), cvv = *(const f32x4*)(PART + ((size_t)grp * 2 + rr) * NUP + DFF + ng);
            if (grp & 127) {
                const float* H = HALO + (size_t)(grp - 1) * 2 * NUP;
                const f32x4 wg0 = *(const f32x4*)(conv_w + ng), wg1 = *(const f32x4*)(conv_w + NUP + ng), wv0 = *(const f32x4*)(conv_w + DFF + ng), wv1 = *(const f32x4*)(conv_w + NUP + DFF + ng);
                const f32x4 hg0 = *(const f32x4*)(H + ng), hg1 = *(const f32x4*)(H + NUP + ng), hv0 = *(const f32x4*)(H + DFF + ng), hv1 = *(const f32x4*)(H + NUP + DFF + ng);
                if (rr == 0) { cgv += wg0 * hg0 + wg1 * hg1; cvv += wv0 * hv0 + wv1 * hv1; }
                else { cgv += wg0 * hg1; cvv += wv0 * hv1; }
            }
            f32x4 a;
#pragma unroll
            for (int j = 0; j < 4; ++j) a[j] = siluf_(cgv[j]) * cvv[j];
            *(u32x2*)(ACT + (size_t)(64 * grp + rr) * DFF + ng) = pack4(a);
        }
    }
    SEAM(9);
    if (IN(10)) {
        pg8::Gemm g{ACT, Wdn_t, T, D, DFF}; pg8::StaticOrder S; S.init(T, D, G, bid); EpiRes E{out, out, ADA + 5120};
        pg8::gemm_phase<EpiRes, pg8::StaticOrder, true, true>(lds, g, S, E);
    }
    SEAM(10);
    if (IN(11)) {
        for (int m = gw; m < T; m += NGW) { float* row = out + (size_t)m * D; f32x4 v[4]; float s = 0.f;
#pragma unroll
            for (int j = 0; j < 4; ++j) { v[j] = *((const f32x4*)row + lane + 64 * j); s += (v[j][0] * v[j][0] + v[j][1] * v[j][1]) + (v[j][2] * v[j][2] + v[j][3] * v[j][3]); }
            const float rstd = __builtin_amdgcn_rsqf(wave_sum(s) * (1.0f / D) + EPS);
#pragma unroll
            for (int j = 0; j < 4; ++j) { const f32x4 gg = *((const f32x4*)norm_final_g + lane + 64 * j); *((f32x4*)row + lane + 64 * j) = v[j] * rstd * gg; } }
    }
#undef IN
#undef SEAM
}


#ifdef DBG_STOP
__global__ void dump_kernel(float* out, const unsigned short* src, size_t ne, const unsigned short* src2) {
    const size_t N = (size_t)T * D;
    for (size_t i = (size_t)blockIdx.x * blockDim.x + threadIdx.x; i < N; i += (size_t)gridDim.x * blockDim.x)
        out[i] = i < ne ? bf2f(src[i]) : (src2 && i - ne < ne ? bf2f(src2[i - ne]) : 0.f);
}
#endif
#ifndef MK_ONE_LAUNCH
#define MK_ONE_LAUNCH 0
#endif
extern "C" void kernel_launch(void* const* d_in, const int* in_sizes, int n_in, void* d_out, int out_size, void* d_ws, size_t ws_size, hipStream_t stream) {
    static int grid = 0;
    const void* kfn = (const void*)mk_fwd<0xFFFu>;
    if (grid == 0) {
        int dev = 0, cus = 0, per_cu = 0;
        (void)hipGetDevice(&dev); (void)hipDeviceGetAttribute(&cus, hipDeviceAttributeMultiprocessorCount, dev);
        if (hipFuncSetAttribute(kfn, hipFuncAttributeMaxDynamicSharedMemorySize, LDS_BYTES) != hipSuccess) { fprintf(stderr, "hipFuncSetAttribute failed\n"); grid = -1; return; }
        if (hipOccupancyMaxActiveBlocksPerMultiprocessor(&per_cu, kfn, NTHR, LDS_BYTES) != hipSuccess || per_cu < 1) { fprintf(stderr, "occupancy query: %d\n", per_cu); per_cu = 1; }
        (void)hipGetLastError();
        grid = cus * per_cu;
        fprintf(stderr, "mk_fwd: grid %d (cus %d x %d), ws %zu\n", grid, cus, per_cu, ws_size);
    }
    if (grid < 0) return;
    (void)hipMemsetAsync((unsigned char*)d_ws + ZERO_OFF, 0, ZERO_BYTES, stream);
    Args a{};
    for (int i = 0; i < 21; ++i) a.in[i] = d_in[i];
    a.out = (float*)d_out; a.ws = (unsigned char*)d_ws;
#if MK_ONE_LAUNCH
    a.ph_lo = 0; a.ph_hi = NPH;
    void* kargs[] = {&a};
    hipError_t e = hipLaunchCooperativeKernel(kfn, dim3(grid), dim3(NTHR), kargs, LDS_BYTES, stream);
    if (e != hipSuccess) fprintf(stderr, "cooperative launch failed: %s (grid %d)\n", hipGetErrorString(e), grid);
#else
#define MK_L(ph) do { a.ph_lo = ph; a.ph_hi = ph + 1; (void)hipFuncSetAttribute((const void*)mk_fwd<(1u << ph)>, hipFuncAttributeMaxDynamicSharedMemorySize, LDS_BYTES); hipLaunchKernelGGL(mk_fwd<(1u << ph)>, dim3(grid), dim3(NTHR), LDS_BYTES, stream, a); } while (0)
#ifdef DBG_STOP
#define MK_LD(ph) do { if (ph < DBG_STOP) MK_L(ph); } while (0)
#ifdef P5_ONLY_G7
#define P5_ONLY 1
#else
#define P5_ONLY 0
#endif
#ifdef P5_SPLIT
#undef MK_LD
#define MK_LD(ph) do { if (ph < DBG_STOP) { if (ph == 5) { (void)hipFuncSetAttribute((const void*)mk_fwd<32u>, hipFuncAttributeMaxDynamicSharedMemorySize, LDS_BYTES); a.ph_lo = 5; a.ph_hi = 6 | 0x100; hipLaunchKernelGGL(mk_fwd<32u>, dim3(grid), dim3(NTHR), LDS_BYTES, stream, a); a.ph_hi = 6 | 0x200; if (!P5_ONLY) hipLaunchKernelGGL(mk_fwd<32u>, dim3(grid), dim3(NTHR), LDS_BYTES, stream, a); } else MK_L(ph); } } while (0)
#endif
    MK_LD(0); MK_LD(1); MK_LD(2); MK_LD(3); MK_LD(4); MK_LD(5); MK_LD(6); MK_LD(7); MK_LD(8); MK_LD(9); MK_LD(10); MK_LD(11);
#ifdef DUMP_OFF
    hipLaunchKernelGGL(dump_kernel, dim3(2048), dim3(256), 0, stream, (float*)d_out, (const unsigned short*)((const unsigned char*)d_ws + (size_t)(DUMP_OFF) * MiB), (size_t)(DUMP_MIB) * MiB / 2,
#ifdef DUMP_OFF2
        (const unsigned short*)((const unsigned char*)d_ws + (size_t)(DUMP_OFF2) * MiB));
#else
        (const unsigned short*)nullptr);
#endif
#endif
#else
    MK_L(0); MK_L(1); MK_L(2); MK_L(3); MK_L(4); MK_L(5); MK_L(6); MK_L(7); MK_L(8); MK_L(9); MK_L(10); MK_L(11);
#endif
#undef MK_L
#endif
}
```

```cpp
#include <hip/hip_runtime.h>
#include <hip/hip_cooperative_groups.h>
#include <cstdio>
#include <cstdint>
#include <cmath>
namespace cg = cooperative_groups;
namespace pg8 {
#define PG8_LAS __attribute__((address_space(3)))
typedef unsigned short bf16_t;
typedef short bf16x8 __attribute__((ext_vector_type(8)));
typedef float f32x4 __attribute__((ext_vector_type(4)));
typedef unsigned u32x4 __attribute__((ext_vector_type(4)));
constexpr int BM = 256, BK = 64, HALF = 128, HTB = HALF * BK * 2  , STAGE_BYTES = 8 * HTB, NXCD = 8, WGM = 8;

__host__ __device__ __forceinline__ int lds_byte(int r, int c) { const int st = (r >> 4) * 2 + (c >> 5), rr = r & 15, cc = c & 31, ob = rr * 64 + cc * 2; return st * 1024 + (ob ^ (((ob >> 9) & 1) << 5)); }
__host__ __device__ __forceinline__ void stage_rc(int b, int& R, int& C) { const int st = b / 1024, sb = b % 1024, swz = sb ^ (((sb >> 9) & 1) << 5); R = (st >> 1) * 16 + swz / 64; C = (st & 1) * 32 + (swz % 64) / 2; }
__host__ __device__ __forceinline__ int perm32(int rho) { const int n = rho >> 4, i = rho & 15; return 8 * (i >> 2) + 4 * n + (i & 3); }

struct Unit { int pm, pn; };
struct Gemm { const bf16_t* A; const bf16_t* Bt; int M, N, K; };

struct StaticOrder {
    int nM, nN, nwg, G, c, base = 0, single = 0, off = 0;
    __host__ __device__ void init(int M, int N, int G_, int c_) { nM = M / BM; nN = N / BM; nwg = nM * nN; G = G_; c = c_; }
    __host__ __device__ bool next(int i, Unit& u) const {
        if (single && i > 0) return false;
        const long L = (long)(i + base) * G + c; if (L >= nwg) return false;
        int wgid = (int)L; { const int q = nwg / NXCD, r = nwg % NXCD, xcd = wgid % NXCD, off = wgid / NXCD; wgid = (xcd < r ? xcd * (q + 1) : r * (q + 1) + (xcd - r) * q) + off; }
        wgid += off;
        const int nig = WGM * nN, gid = wgid / nig, fm = gid * WGM, gsz = (nM - fm) < WGM ? (nM - fm) : WGM;
        u.pm = fm + ((wgid % nig) % gsz); u.pn = (wgid % nig) / gsz; return true;
    }
    __device__ __forceinline__ void a_ready(const Unit&) const {}
    __device__ __forceinline__ void done(const Unit&) const {}
};

__device__ __forceinline__ unsigned cvt_pk_bf16(float lo, float hi) { unsigned r; asm volatile("v_cvt_pk_bf16_f32 %0, %1, %2" : "=v"(r) : "v"(lo), "v"(hi)); return r; }
typedef float f32x2 __attribute__((ext_vector_type(2)));
template <class E, class = void> struct epi_keep { static constexpr bool value = false; };
template <class E> struct epi_keep<E, decltype((void)E::KEEP)> { static constexpr bool value = E::KEEP; };
template <class Epi, class Sched, bool ALIGN_EPI = false, bool SP2 = false>
__device__ __forceinline__ void gemm_phase(PG8_LAS unsigned char* lds, const Gemm g, const Sched& S, const Epi& E) {
    int tid_ = threadIdx.x; asm volatile("" : "+v"(tid_));
    const int tid = tid_, wid = __builtin_amdgcn_readfirstlane(tid >> 6), lane = tid & 63, wr = wid >> 2, wc = wid & 3, fr = lane & 15, fq = lane >> 4;
    int K_ = g.K; asm volatile("" : "+s"(K_));
    const int K = K_, nt = K / BK;
    unsigned voffA[2], voffB[2];
#pragma unroll
    for (int i = 0; i < 2; ++i) { int R, C; stage_rc(tid * 16 + i * 8192, R, C); const int Rb = Epi::PERM ? ((R & ~31) + perm32(R & 31)) : R;
        voffA[i] = (unsigned)(R * K + C) * 2u; voffB[i] = (unsigned)(Rb * K + C) * 2u; }
    const size_t kstep = (size_t)(BK * 2);
    const size_t hstep = (size_t)HALF * K * 2;
    const size_t tstep = 2 * hstep;
    const unsigned ldsw = (unsigned)wid * 1024u;
    const int aoff = lds_byte(wr * 64 + fr, fq * 8), boff = lds_byte(wc * 32 + fr, fq * 8);
#define PG8_SA(b, h) (((b) * 2 + (h)) * HTB)
#define PG8_SB(b, h) ((4 + (b) * 2 + (h)) * HTB)
#define PG8_STAGE(bufoff, gbase, voff) do { _Pragma("unroll") for (int _i = 0; _i < 2; ++_i) \
        __builtin_amdgcn_global_load_lds((const unsigned*)((const char*)(gbase) + (voff)[_i]), (PG8_LAS unsigned*)(lds + (bufoff) + ldsw + _i * 8192), 16, 0, 0); } while (0)
#define PG8_LDA(dst, b, h) do { _Pragma("unroll") for (int m = 0; m < 4; ++m) _Pragma("unroll") for (int k = 0; k < 2; ++k) dst[m][k] = *(const PG8_LAS bf16x8*)(lds + PG8_SA(b, h) + aoff + m * 2048 + k * 1024); } while (0)
#define PG8_LDB(dst, b, h) do { _Pragma("unroll") for (int n = 0; n < 2; ++n) _Pragma("unroll") for (int k = 0; k < 2; ++k) dst[n][k] = *(const PG8_LAS bf16x8*)(lds + PG8_SB(b, h) + boff + n * 2048 + k * 1024); } while (0)
#define PG8_MMA(ai, bj, At, Bt) do { __builtin_amdgcn_s_setprio(1); _Pragma("unroll") for (int m = 0; m < 4; ++m) _Pragma("unroll") for (int n = 0; n < 2; ++n) _Pragma("unroll") for (int k = 0; k < 2; ++k) \
        acc[ai][bj][m][n] = __builtin_amdgcn_mfma_f32_16x16x32_bf16(Bt[n][k], At[m][k], acc[ai][bj][m][n], 0, 0, 0); __builtin_amdgcn_s_setprio(0); } while (0)
#define PG8_WAIT_V(n) asm volatile("s_waitcnt vmcnt(" #n ")" ::: "memory")
#define PG8_WAIT_L(n) asm volatile("s_waitcnt lgkmcnt(" #n ")" ::: "memory")
#define PG8_BAR __builtin_amdgcn_s_barrier()
#define PG8_SCHED __builtin_amdgcn_sched_barrier(0)
    Unit cur, nxt; int ui = 0;
    if (!S.next(0, cur)) return;
    f32x4 acc[2][2][4][2];
#pragma unroll
    for (int a = 0; a < 2; ++a)
#pragma unroll
        for (int b = 0; b < 2; ++b)
#pragma unroll
            for (int m = 0; m < 4; ++m)
#pragma unroll
                for (int n = 0; n < 2; ++n) acc[a][b][m][n] = (f32x4){0.f, 0.f, 0.f, 0.f};
    bf16x8 At[4][2], B0[2][2], B1[2][2];
    const char* cA = (const char*)g.A + (size_t)cur.pm * tstep; const char* cB = (const char*)g.Bt + (size_t)cur.pn * tstep;
    S.a_ready(cur);
    if constexpr (SP2) {
        PG8_STAGE(PG8_SB(0, 0), cB, voffB); PG8_STAGE(PG8_SB(0, 1), cB + hstep, voffB); PG8_STAGE(PG8_SA(0, 0), cA, voffA); PG8_STAGE(PG8_SA(0, 1), cA + hstep, voffA);
        if (wr == 1) PG8_BAR;
        PG8_WAIT_V(2); PG8_BAR;
        PG8_STAGE(PG8_SB(1, 0), cB + kstep, voffB); PG8_STAGE(PG8_SA(1, 0), cA + kstep, voffA); PG8_STAGE(PG8_SB(1, 1), cB + hstep + kstep, voffB);
        PG8_WAIT_V(6); PG8_BAR;
    } else {
        PG8_STAGE(PG8_SB(0, 0), cB, voffB); PG8_STAGE(PG8_SA(0, 0), cA, voffA); PG8_STAGE(PG8_SB(0, 1), cB + hstep, voffB); PG8_STAGE(PG8_SA(0, 1), cA + hstep, voffA);
        if (wr == 1) PG8_BAR;
        PG8_WAIT_V(4); PG8_BAR;
        PG8_STAGE(PG8_SB(1, 0), cB + kstep, voffB); PG8_STAGE(PG8_SA(1, 0), cA + kstep, voffA); PG8_STAGE(PG8_SB(1, 1), cB + hstep + kstep, voffB);
        PG8_WAIT_V(6); PG8_BAR;
    }
    for (;;) {
        const bool has_next = S.next(ui + 1, nxt);
        const char* nA = has_next ? (const char*)g.A + (size_t)nxt.pm * tstep : cA; const char* nB = has_next ? (const char*)g.Bt + (size_t)nxt.pn * tstep : cB;
        for (int t = 0; t < nt; t += 2) {
            const bool last = (t == nt - 2);
            const char* a1 = cA + (size_t)(t + 1) * kstep;
            const char* a2 = last ? nA : cA + (size_t)(t + 2) * kstep; const char* b2 = last ? nB : cB + (size_t)(t + 2) * kstep;
            const char* a3 = a2 + kstep; const char* b3 = b2 + kstep;
            if (last && has_next) S.a_ready(nxt);
            if constexpr (SP2) {
            PG8_LDB(B0, 0, 0); PG8_LDB(B1, 0, 1); PG8_SCHED; PG8_LDA(At, 0, 0); PG8_STAGE(PG8_SA(1, 1), a1 + hstep, voffA);
            PG8_WAIT_V(8); PG8_WAIT_L(0); PG8_BAR; PG8_MMA(0, 0, At, B0); PG8_MMA(0, 1, At, B1); PG8_BAR; PG8_SCHED;
            PG8_LDA(At, 0, 1); PG8_STAGE(PG8_SB(0, 0), b2, voffB); PG8_STAGE(PG8_SB(0, 1), b2 + hstep, voffB); PG8_STAGE(PG8_SA(0, 0), a2, voffA);
            PG8_WAIT_V(8); PG8_WAIT_L(0); PG8_BAR; PG8_MMA(1, 0, At, B0); PG8_MMA(1, 1, At, B1); PG8_BAR; PG8_SCHED;
            PG8_LDB(B0, 1, 0); PG8_LDB(B1, 1, 1); PG8_SCHED; PG8_LDA(At, 1, 0); PG8_STAGE(PG8_SA(0, 1), a2 + hstep, voffA);
            PG8_WAIT_V(8); PG8_WAIT_L(0); PG8_BAR; PG8_MMA(0, 0, At, B0); PG8_MMA(0, 1, At, B1); PG8_BAR; PG8_SCHED;
            PG8_LDA(At, 1, 1); PG8_STAGE(PG8_SB(1, 0), b3, voffB); PG8_STAGE(PG8_SB(1, 1), b3 + hstep, voffB); PG8_STAGE(PG8_SA(1, 0), a3, voffA);
            PG8_WAIT_V(8); PG8_WAIT_L(0); PG8_BAR; PG8_MMA(1, 0, At, B0); PG8_MMA(1, 1, At, B1); PG8_BAR; PG8_SCHED;
            } else {
            PG8_LDB(B0, 0, 0); PG8_SCHED; PG8_LDA(At, 0, 0); PG8_STAGE(PG8_SA(1, 1), a1 + hstep, voffA);
            PG8_WAIT_L(8); PG8_BAR; PG8_WAIT_L(0); PG8_MMA(0, 0, At, B0); PG8_BAR; PG8_SCHED;
            PG8_LDB(B1, 0, 1); PG8_STAGE(PG8_SB(0, 0), b2, voffB);
            PG8_BAR; PG8_WAIT_L(0); PG8_MMA(0, 1, At, B1); PG8_BAR;
            PG8_LDA(At, 0, 1); PG8_STAGE(PG8_SA(0, 0), a2, voffA);
            PG8_BAR; PG8_WAIT_L(0); PG8_MMA(1, 0, At, B0); PG8_BAR; PG8_SCHED;
            PG8_STAGE(PG8_SB(0, 1), b2 + hstep, voffB);
            PG8_WAIT_V(6); PG8_BAR; PG8_MMA(1, 1, At, B1); PG8_BAR;
            PG8_LDB(B0, 1, 0); PG8_SCHED; PG8_LDA(At, 1, 0); PG8_STAGE(PG8_SA(0, 1), a2 + hstep, voffA);
            PG8_WAIT_L(8); PG8_BAR; PG8_WAIT_L(0); PG8_MMA(0, 0, At, B0); PG8_BAR; PG8_SCHED;
            PG8_LDB(B1, 1, 1); PG8_STAGE(PG8_SB(1, 0), b3, voffB);
            PG8_BAR; PG8_WAIT_L(0); PG8_MMA(0, 1, At, B1); PG8_BAR;
            PG8_LDA(At, 1, 1); PG8_STAGE(PG8_SA(1, 0), a3, voffA);
            PG8_BAR; PG8_WAIT_L(0); PG8_MMA(1, 0, At, B0); PG8_BAR; PG8_SCHED;
            PG8_STAGE(PG8_SB(1, 1), b3 + hstep, voffB);
            PG8_WAIT_V(6); PG8_BAR; PG8_MMA(1, 1, At, B1); PG8_BAR;
            }
        }
        if constexpr (ALIGN_EPI) { if (wr == 0) PG8_BAR; }
        if constexpr (!Epi::AFTER_DRAIN) { E(acc, cur, wr, wc, fr, fq); S.done(cur); }
        if (!has_next) break;
        bool keep_acc = false; if constexpr (epi_keep<Epi>::value) keep_acc = E.keep_acc(cur);
        if (!keep_acc)
#pragma unroll
        for (int a = 0; a < 2; ++a)
#pragma unroll
            for (int b = 0; b < 2; ++b)
#pragma unroll
                for (int m = 0; m < 4; ++m)
#pragma unroll
                    for (int n = 0; n < 2; ++n) acc[a][b][m][n] = (f32x4){0.f, 0.f, 0.f, 0.f};
        cur = nxt; cA = nA; cB = nB; ++ui;
        if constexpr (ALIGN_EPI) { if (wr == 1) PG8_BAR; }
    }
    PG8_WAIT_V(0);
    if constexpr (!ALIGN_EPI) { if (wr == 0) PG8_BAR; }
    PG8_BAR;
    if constexpr (Epi::AFTER_DRAIN) { E.fused(acc, cur, wr, wc, fr, fq, lds, wid, lane); S.done(cur); }
#undef PG8_SA
#undef PG8_SB
#undef PG8_STAGE
#undef PG8_LDA
#undef PG8_LDB
#undef PG8_MMA
#undef PG8_WAIT_V
#undef PG8_WAIT_L
#undef PG8_BAR
#undef PG8_SCHED
}
}
#ifndef MP_REPS
#define MP_REPS 1
#endif
#ifndef MP1_REPS
#define MP1_REPS 1
#endif
#ifndef SM_REPS
#define SM_REPS 1
#endif
#ifndef P8_REPS
#define P8_REPS 1
#endif
#define LAS __attribute__((address_space(3)))
using pg8::bf16_t; using pg8::bf16x8; using pg8::f32x4; using pg8::u32x4; using pg8::Unit;
typedef float f32x2_t __attribute__((ext_vector_type(2))); typedef __bf16 bf16x2_t __attribute__((ext_vector_type(2)));
__device__ __forceinline__ unsigned cvt_pk_bf16(float lo, float hi) { f32x2_t v = {lo, hi}; bf16x2_t b = __builtin_convertvector(v, bf16x2_t); return __builtin_bit_cast(unsigned, b); }
typedef float f32x16 __attribute__((ext_vector_type(16)));
typedef unsigned u32x2 __attribute__((ext_vector_type(2)));

constexpr int NWAVES = 8, NTHR = 512;
constexpr int BATCH = 2, SEQ = 8192, T = BATCH * SEQ, D = 1024;
constexpr int DIN = 4264, DINP = 4352, NPROJ = 3840;
constexpr int QR = 384, KVR = 256, DFF = 2816, NUP = 5632;
constexpr float EPS = 1e-6f;
constexpr float LOG2E = 1.4426950408889634f;
constexpr float MLA_C = 0.10206207261596577f * LOG2E;
constexpr float FOX_C = 0.125f * LOG2E;
constexpr size_t MiB = 1u << 20;
constexpr size_t WS_WIN = 0, WS_WUQ = 9 * MiB, WS_WUKV = 10 * MiB, WS_WOM = 11 * MiB, WS_WOF = 12 * MiB, WS_WOUT = 13 * MiB, WS_WUP = 15 * MiB, WS_WDN = 26 * MiB;
constexpr size_t WS_HA = 32 * MiB;
constexpr size_t WS_CQ = 64 * MiB, WS_CKV = 76 * MiB, WS_KR = 84 * MiB;
constexpr size_t WS_SMALL = 85 * MiB;
constexpr size_t WS_ADA = WS_SMALL, WS_SSQ = WS_SMALL + 65536, WS_SSK = WS_SMALL + 2 * 65536, WS_BAR = WS_SMALL + 3 * 65536, WS_SS1 = WS_BAR + 16384, WS_SS2 = WS_SS1 + 65536, WS_CNT = WS_SS2 + 65536, ZERO_OFF = WS_SSQ, WS_NRM = WS_CNT + 32768, ZERO_BYTES = 2 * 65536 + 16384 + 2 * 65536 + 32768 + 256;
constexpr size_t WS_CS = 86 * MiB;
constexpr size_t WS_LF = 88 * MiB;
constexpr size_t WS_FB = 89 * MiB;
constexpr size_t WS_NF = 91 * MiB;
constexpr size_t WS_FQ = 96 * MiB, WS_FK = 112 * MiB, WS_FVT = 128 * MiB, WS_GM = 144 * MiB, WS_GF = 176 * MiB;
constexpr size_t WS_KN = 208 * MiB, WS_VMT = 224 * MiB, WS_OM = 240 * MiB, WS_OF = 64 * MiB;
constexpr size_t WS_Q = WS_HA, WS_T1 = WS_HA, WS_H2 = WS_HA, WS_Y = 96 * MiB, WS_ACT = 96 * MiB, WS_HALO = 184 * MiB, WS_PART = 195 * MiB;
constexpr int LDS_BYTES = 135168;

__device__ const double INVF[16] = {1.0, 0.5623413251903491, 0.31622776601683794, 0.1778279410038923, 0.1, 0.05623413251903491, 0.03162277660168379, 0.01778279410038923, 0.01, 0.005623413251903491, 0.0031622776601683794, 0.0017782794100389228, 0.001, 0.0005623413251903491, 0.00031622776601683794, 0.00017782794100389227};

__device__ __forceinline__ float bf2f(unsigned short b) { return __builtin_bit_cast(float, (unsigned)b << 16); }
__device__ __forceinline__ float bflo(unsigned w) { return __builtin_bit_cast(float, w << 16); }
__device__ __forceinline__ float bfhi(unsigned w) { return __builtin_bit_cast(float, w & 0xffff0000u); }
__device__ __forceinline__ unsigned short f2bf(float f) { return (unsigned short)(cvt_pk_bf16(f, 0.f) & 0xffffu); }
__device__ __forceinline__ u32x2 pack4(f32x4 v) { u32x2 w; w.x = cvt_pk_bf16(v[0], v[1]); w.y = cvt_pk_bf16(v[2], v[3]); return w; }
__device__ __forceinline__ void st_pair16(bf16_t* p0, u32x2 w0, u32x2 w1, int fq) {
    const auto sx = __builtin_amdgcn_permlane16_swap(w0.x, w1.x, false, false), sy = __builtin_amdgcn_permlane16_swap(w0.y, w1.y, false, false);
    *(u32x4*)(p0 + ((fq & 1) ? 12 : 0)) = (u32x4){sx[0], sy[0], sx[1], sy[1]};
}
__device__ __forceinline__ void ld_pair16(const bf16_t* p0, int fq, u32x2& w0, u32x2& w1) {
    const u32x4 t = *(const u32x4*)(p0 + ((fq & 1) ? 12 : 0));
    const auto sx = __builtin_amdgcn_permlane16_swap(t.x, t.z, false, false), sy = __builtin_amdgcn_permlane16_swap(t.y, t.w, false, false);
    w0 = (u32x2){sx[0], sy[0]}; w1 = (u32x2){sx[1], sy[1]};
}
__device__ __forceinline__ void st_pair16_if(bf16_t* p0, u32x2 w0, u32x2 w1, int fq, bool doit) {
    const auto sx = __builtin_amdgcn_permlane16_swap(w0.x, w1.x, false, false), sy = __builtin_amdgcn_permlane16_swap(w0.y, w1.y, false, false);
    if (doit) *(u32x4*)(p0 + ((fq & 1) ? 12 : 0)) = (u32x4){sx[0], sy[0], sx[1], sy[1]};
}
__device__ __forceinline__ float wave_sum(float v) {
#pragma unroll
    for (int o = 1; o < 64; o <<= 1) v += __shfl_xor(v, o);
    return v;
}
__device__ __forceinline__ float sigmoidf_(float x) { return __builtin_amdgcn_rcpf(1.0f + __expf(-x)); }
__device__ __forceinline__ float siluf_(float x) { return x * sigmoidf_(x); }

typedef const f32x4 (&AccRef)[2][2][4][2];

template <int BJ0, int BJ1, bool SSQ, bool RSC>
__device__ __forceinline__ void epi_store(AccRef acc, int row0, bf16_t* dst, int ld, int col0, float scale, float* ssq, const float* rss, float invk, int fq) {
#pragma unroll
    for (int ai = 0; ai < 2; ++ai)
#pragma unroll
        for (int m = 0; m < 4; ++m) {
            const int r = row0 + 128 * ai + 16 * m; float s = 0.f, sc = scale;
            if (RSC) sc *= __builtin_amdgcn_rsqf(rss[r] * invk + EPS);
#pragma unroll
            for (int bj = BJ0; bj < BJ1; ++bj) { const f32x4 v0 = acc[ai][bj][m][0], v1 = acc[ai][bj][m][1];
                if (SSQ) s += ((v0[0] * v0[0] + v0[1] * v0[1]) + (v0[2] * v0[2] + v0[3] * v0[3])) + ((v1[0] * v1[0] + v1[1] * v1[1]) + (v1[2] * v1[2] + v1[3] * v1[3]));
                st_pair16(dst + (size_t)r * ld + col0 + (bj - BJ0) * 128, pack4(v0 * sc), pack4(v1 * sc), fq); }
            if (SSQ) { s += __shfl_xor(s, 16); s += __shfl_xor(s, 32); if (fq == 0) atomicAdd(ssq + r, s); }
        }
}

struct EpiProj {
    static constexpr bool PERM = false, AFTER_DRAIN = false;
    bf16_t *CQ, *CKV, *KR, *FQ, *FK, *GM, *GF; float *LF, *SSQ, *SSK; const float *CS, *bforget;
    __device__ __forceinline__ void operator()(AccRef acc, const Unit& u, int wr, int wc, int fr_, int fq_) const {
        int ln_ = threadIdx.x & 63; asm volatile("" : "+v"(ln_)); const int fr = ln_ & 15, fq = ln_ >> 4; (void)fr_; (void)fq_;
        const int pn = u.pn, row0 = u.pm * 256 + wr * 64 + fr, cw = wc * 32 + 4 * fq;
        if (pn == 0) { epi_store<0, 2, true, false>(acc, row0, CQ, QR, cw, 1.f, SSQ, nullptr, 0.f, fq); }
        else if (pn == 1) {
            epi_store<0, 1, true, false>(acc, row0, CQ, QR, 256 + cw, 1.f, SSQ, nullptr, 0.f, fq);
            if (wc == 0) {
#pragma unroll
                for (int ai = 0; ai < 2; ++ai)
#pragma unroll
                    for (int m = 0; m < 4; ++m) { const int r = row0 + 128 * ai + 16 * m;
                        const f32x4 c = *(const f32x4*)(CS + (size_t)r * 16 + 4 * fq), s = *(const f32x4*)(CS + (size_t)T * 16 + (size_t)r * 16 + 4 * fq);
                        const f32x4 x1 = acc[ai][1][m][0], x2 = acc[ai][1][m][1];
                        st_pair16(KR + (size_t)r * 32 + 4 * fq, pack4(x1 * c - x2 * s), pack4(x2 * c + x1 * s), fq); }
            } else if (wc == 1) {
                if (fq < 2) {
                    const f32x4 bfg = *(const f32x4*)(bforget + 4 * fq);
#pragma unroll
                    for (int ai = 0; ai < 2; ++ai)
#pragma unroll
                        for (int m = 0; m < 4; ++m) { const int r = row0 + 128 * ai + 16 * m; const f32x4 z = acc[ai][1][m][0] + bfg; f32x4 o;
#pragma unroll
                            for (int j = 0; j < 4; ++j) o[j] = fminf(z[j], 0.f) - log1pf(expf(-fabsf(z[j])));
                            *(f32x4*)(LF + (size_t)r * 8 + 4 * fq) = o; }
                }
            }
        }
        else if (pn == 2) { epi_store<0, 2, true, false>(acc, row0, CKV, KVR, cw, 1.f, SSK, nullptr, 0.f, fq); }
        else if (pn <= 4) { epi_store<0, 2, false, false>(acc, row0, FQ, 512, (pn - 3) * 256 + cw, FOX_C, nullptr, nullptr, 0.f, fq); }
        else if (pn <= 6) { epi_store<0, 2, false, false>(acc, row0, FK, 512, (pn - 5) * 256 + cw, 1.f, nullptr, nullptr, 0.f, fq); }
        else {
            bf16_t* G = pn <= 10 ? GM : GF; const int cb = ((pn - 7) & 3) * 256 + cw;
#pragma unroll
            for (int ai = 0; ai < 2; ++ai)
#pragma unroll
                for (int m = 0; m < 4; ++m) { const int r = row0 + 128 * ai + 16 * m;
#pragma unroll
                    for (int bj = 0; bj < 2; ++bj) { f32x4 o[2];
#pragma unroll
                        for (int n = 0; n < 2; ++n) { const f32x4 v = acc[ai][bj][m][n];
#pragma unroll
                            for (int j = 0; j < 4; ++j) o[n][j] = fmaxf(sigmoidf_(v[j]), 8.6736174e-19f); }
                        st_pair16(G + (size_t)r * D + cb + bj * 128, pack4(o[0]), pack4(o[1]), fq); } }
        }
    }
};

struct EpiVt {
    static constexpr bool PERM = false, AFTER_DRAIN = false;
    bf16_t* dst; const float* ss; float invk;
    __device__ __forceinline__ void operator()(AccRef acc, const Unit& u, int wr, int wc, int fr_, int fq_) const {
        int ln_ = threadIdx.x & 63; asm volatile("" : "+v"(ln_)); const int fr = ln_ & 15, fq = ln_ >> 4; (void)fr_; (void)fq_;
        const int row0 = u.pm * 256 + wr * 64 + fr, c0 = u.pn * 256 + wc * 32 + 4 * fq;
        f32x4 sc[2][2];
#pragma unroll
        for (int bj = 0; bj < 2; ++bj)
#pragma unroll
            for (int n = 0; n < 2; ++n) { sc[bj][n] = (f32x4){1.f, 1.f, 1.f, 1.f};
                if (ss) { const f32x4 q = *(const f32x4*)(ss + c0 + bj * 128 + 16 * n);
#pragma unroll
                    for (int j = 0; j < 4; ++j) sc[bj][n][j] = __builtin_amdgcn_rsqf(q[j] * invk + EPS); } }
#pragma unroll
        for (int ai = 0; ai < 2; ++ai)
#pragma unroll
            for (int m = 0; m < 4; ++m) { const int r = row0 + 128 * ai + 16 * m;
#pragma unroll
                for (int bj = 0; bj < 2; ++bj)
                    st_pair16(dst + (size_t)r * T + c0 + bj * 128, pack4(acc[ai][bj][m][0] * sc[bj][0]), pack4(acc[ai][bj][m][1] * sc[bj][1]), fq); }
    }
};

struct EpiQ {
    static constexpr bool PERM = false, AFTER_DRAIN = false;
    bf16_t* Q; const float *SSQ, *CS;
    __device__ __forceinline__ void operator()(AccRef acc, const Unit& u, int wr, int wc, int fr_, int fq_) const {
        int ln_ = threadIdx.x & 63; asm volatile("" : "+v"(ln_)); const int fr = ln_ & 15, fq = ln_ >> 4; (void)fr_; (void)fq_;
        const int row0 = u.pm * 256 + wr * 64 + fr;
#pragma unroll
        for (int bj = 0; bj < 2; ++bj) { const int g32 = 8 * u.pn + 4 * bj + wc; const bool isrope = (g32 % 3) == 2;
            bf16_t* qb = Q + u.pn * 256 + bj * 128 + wc * 32 + 4 * fq;
#pragma unroll
            for (int ai = 0; ai < 2; ++ai)
#pragma unroll
                for (int m = 0; m < 4; ++m) { const int r = row0 + 128 * ai + 16 * m;
                    const float rs = __builtin_amdgcn_rsqf(SSQ[r] * (1.0f / QR) + EPS) * MLA_C;
                    f32x4 v0 = acc[ai][bj][m][0] * rs, v1 = acc[ai][bj][m][1] * rs;
                    if (isrope) { const f32x4 c = *(const f32x4*)(CS + (size_t)r * 16 + 4 * fq), s = *(const f32x4*)(CS + (size_t)T * 16 + (size_t)r * 16 + 4 * fq);
                        const f32x4 o0 = v0 * c - v1 * s, o1 = v1 * c + v0 * s; v0 = o0; v1 = o1; }
                    bf16_t* p = qb + (size_t)r * 768;
                    st_pair16(p, pack4(v0), pack4(v1), fq);
                    asm volatile("" ::: "memory"); } }
    }
};

struct EpiKN {
    static constexpr bool PERM = false, AFTER_DRAIN = false;
    bf16_t* KN; const float* SSK;
    __device__ __forceinline__ void operator()(AccRef acc, const Unit& u, int wr, int wc, int fr_, int fq_) const {
        int ln_ = threadIdx.x & 63; asm volatile("" : "+v"(ln_)); const int fr = ln_ & 15, fq = ln_ >> 4; (void)fr_; (void)fq_;
        epi_store<0, 2, false, true>(acc, u.pm * 256 + wr * 64 + fr, KN, 512, u.pn * 256 + wc * 32 + 4 * fq, 1.f, nullptr, SSK, 1.0f / KVR, fq);
    }
};

template <bool SECOND> struct EpiGate {
    static constexpr bool PERM = false, AFTER_DRAIN = false;
    const bf16_t* G; const bf16_t* T1; bf16_t* O;
    __device__ __forceinline__ void operator()(AccRef acc, const Unit& u, int wr, int wc, int fr_, int fq_) const {
        int ln_ = threadIdx.x & 63; asm volatile("" : "+v"(ln_)); const int fr = ln_ & 15, fq = ln_ >> 4; (void)fr_; (void)fq_;
        const int row0 = u.pm * 256 + wr * 64 + fr, c0 = u.pn * 256 + wc * 32 + 4 * fq;
#pragma unroll
        for (int ai = 0; ai < 2; ++ai)
#pragma unroll
            for (int m = 0; m < 4; ++m) { const size_t ro = (size_t)(row0 + 128 * ai + 16 * m) * D + c0;
#pragma unroll
                for (int bj = 0; bj < 2; ++bj)
#pragma unroll
                    for (int n = 0; n < 2; ++n) { const size_t o = ro + bj * 128 + 16 * n; const u32x2 g = *(const u32x2*)(G + o);
                        f32x4 v = acc[ai][bj][m][n] * (f32x4){bflo(g.x), bfhi(g.x), bflo(g.y), bfhi(g.y)};
                        if (SECOND) { const u32x2 t = *(const u32x2*)(T1 + o); v += (f32x4){bflo(t.x), bfhi(t.x), bflo(t.y), bfhi(t.y)}; }
                        *(u32x2*)(O + o) = pack4(v); } }
    }
};

constexpr int PAIR_DPM = (int)(((long long)WS_OF - (long long)WS_OM) / (256 * 512 * 2)), PAIR_DPN = (int)((WS_WOF - WS_WOM) / (256 * 512 * 2));
static_assert((long long)PAIR_DPM * (256 * 512 * 2) == (long long)WS_OF - (long long)WS_OM && (size_t)PAIR_DPN * (256 * 512 * 2) == WS_WOF - WS_WOM, "pair offsets are whole tiles");
struct PairOrder {
    pg8::StaticOrder S0;
    __device__ bool next(int i, Unit& u) const { if (!S0.next(i >> 1, u)) return false; if (i & 1) { u.pm += PAIR_DPM; u.pn += PAIR_DPN; } return true; }
    __device__ __forceinline__ void a_ready(const Unit&) const {}
    __device__ __forceinline__ void done(const Unit&) const {}
};
struct EpiGate2 {
    static constexpr bool PERM = false, AFTER_DRAIN = false, KEEP = true;
    const bf16_t *GMp, *GFp; bf16_t* Yp;
    __device__ __forceinline__ bool keep_acc(const Unit& u) const { return u.pn < 4; }
    __device__ __forceinline__ void operator()(f32x4 (&acc)[2][2][4][2], const Unit& u, int wr, int wc, int fr_, int fq_) const {
        int ln_ = threadIdx.x & 63; asm volatile("" : "+v"(ln_)); const int fr = ln_ & 15, fq = ln_ >> 4; (void)fr_; (void)fq_;
        const bool first = u.pn < 4; const int pm = first ? u.pm : u.pm - PAIR_DPM, pn = first ? u.pn : u.pn - PAIR_DPN;
        const int row0 = pm * 256 + wr * 64 + fr, c0 = pn * 256 + wc * 32 + 4 * fq;
#pragma unroll
        for (int ai = 0; ai < 2; ++ai)
#pragma unroll
            for (int m = 0; m < 4; ++m) { const size_t ro = (size_t)(row0 + 128 * ai + 16 * m) * D + c0;
#pragma unroll
                for (int bj = 0; bj < 2; ++bj) { u32x2 yw[2], gfw[2], gmw[2]; ld_pair16(GFp + ro + bj * 128, fq, gfw[0], gfw[1]);
                    if (first) ld_pair16(GMp + ro + bj * 128, fq, gmw[0], gmw[1]); else { gmw[0] = (u32x2){0u, 0u}; gmw[1] = gmw[0]; }
#pragma unroll
                    for (int n = 0; n < 2; ++n) { const u32x2 gf = gfw[n];
                        const f32x4 s2 = (f32x4){bflo(gf.x), bfhi(gf.x), bflo(gf.y), bfhi(gf.y)};
                        if (first) { const u32x2 gm = gmw[n]; f32x4 rt;
#pragma unroll
                            for (int j = 0; j < 4; ++j) rt[j] = __builtin_amdgcn_rcpf(s2[j]);
                            acc[ai][bj][m][n] = acc[ai][bj][m][n] * ((f32x4){bflo(gm.x), bfhi(gm.x), bflo(gm.y), bfhi(gm.y)} * rt); yw[n] = (u32x2){0u, 0u}; }
                        else yw[n] = pack4(acc[ai][bj][m][n] * s2); }
                    if (!first) st_pair16(Yp + ro + bj * 128, yw[0], yw[1], fq); }
                asm volatile("" ::: "memory"); }
    }
};

struct EpiRes {
    static constexpr bool PERM = false, AFTER_DRAIN = false;
    const float* base; float* out; const float* gate;
    __device__ __forceinline__ void operator()(AccRef acc, const Unit& u, int wr, int wc, int fr_, int fq_) const {
        int ln_ = threadIdx.x & 63; asm volatile("" : "+v"(ln_)); const int fr = ln_ & 15, fq = ln_ >> 4; (void)fr_; (void)fq_;
        const int row0 = u.pm * 256 + wr * 64 + fr, c0 = u.pn * 256 + wc * 32 + 4 * fq; const float* gp = gate + (u.pm >> 5) * 6144 + c0;
        f32x4 gv[2][2];
#pragma unroll
        for (int bj = 0; bj < 2; ++bj)
#pragma unroll
            for (int n = 0; n < 2; ++n) gv[bj][n] = *(const f32x4*)(gp + bj * 128 + 16 * n);
#pragma unroll
        for (int ai = 0; ai < 2; ++ai)
#pragma unroll
            for (int m = 0; m < 4; ++m) { const size_t ro = (size_t)(row0 + 128 * ai + 16 * m) * D + c0;
#pragma unroll
                for (int bj = 0; bj < 2; ++bj)
#pragma unroll
                    for (int n = 0; n < 2; ++n) { const size_t o = ro + bj * 128 + 16 * n; const f32x4 b = *(const f32x4*)(base + o);
                        *(f32x4*)(out + o) = b + gv[bj][n] * acc[ai][bj][m][n]; }
                asm volatile("" ::: "memory"); }
    }
};

template <bool FINAL> struct EpiResNorm {
    static constexpr bool PERM = false, AFTER_DRAIN = true;
    const float* base; float* out; const float* gate; float* ss; unsigned* cnt; const float* g; const float* sc; const float* sh; bf16_t* H;
    __device__ __forceinline__ void fused(f32x4 (&acc)[2][2][4][2], const Unit& u, int wr, int wc, int fr_, int fq_, LAS unsigned char* lds, int wid, int lane_) const {
        int ln_ = threadIdx.x & 63; asm volatile("" : "+v"(ln_)); const int fr = ln_ & 15, fq = ln_ >> 4; (void)fr_; (void)fq_; (void)lds; (void)wid; (void)lane_;
        const int row0 = u.pm * 256 + wr * 64 + fr, c0 = u.pn * 256 + wc * 32 + 4 * fq, b = u.pm >> 5; const float* gp = gate + b * 6144 + c0;
        {   f32x4 gv[2][2];
#pragma unroll
            for (int bj = 0; bj < 2; ++bj)
#pragma unroll
                for (int n = 0; n < 2; ++n) gv[bj][n] = *(const f32x4*)(gp + bj * 128 + 16 * n);
#pragma unroll
            for (int ai = 0; ai < 2; ++ai)
#pragma unroll
                for (int m = 0; m < 4; ++m) { const int r = row0 + 128 * ai + 16 * m; const size_t ro = (size_t)r * D + c0; float s = 0.f;
#pragma unroll
                    for (int bj = 0; bj < 2; ++bj)
#pragma unroll
                        for (int n = 0; n < 2; ++n) { const size_t o = ro + bj * 128 + 16 * n; const f32x4 xn = *(const f32x4*)(base + o) + gv[bj][n] * acc[ai][bj][m][n];
                            acc[ai][bj][m][n] = xn; s += (xn[0] * xn[0] + xn[1] * xn[1]) + (xn[2] * xn[2] + xn[3] * xn[3]); }
                    s += __shfl_xor(s, 16); s += __shfl_xor(s, 32); if (fq == 0) atomicAdd(ss + r, s);
                    asm volatile("" ::: "memory"); } }
        asm volatile("s_waitcnt vmcnt(0)" ::: "memory");
        __syncthreads();
        if (threadIdx.x == 0) {
            unsigned* cw = cnt + 64 * u.pm;
            __hip_atomic_fetch_add(cw, 1u, __ATOMIC_RELAXED, __HIP_MEMORY_SCOPE_AGENT);
        }
        if (!FINAL) {
#pragma unroll
            for (int ai = 0; ai < 2; ++ai)
#pragma unroll
                for (int m = 0; m < 4; ++m) { const size_t ro = (size_t)(row0 + 128 * ai + 16 * m) * D + c0;
#pragma unroll
                    for (int bj = 0; bj < 2; ++bj)
#pragma unroll
                        for (int n = 0; n < 2; ++n) *(f32x4*)(out + ro + bj * 128 + 16 * n) = acc[ai][bj][m][n]; }
        }
        if (threadIdx.x == 0) {
            unsigned* cw = cnt + 64 * u.pm;
            unsigned sp = 0;
            while (__hip_atomic_load(cw, __ATOMIC_RELAXED, __HIP_MEMORY_SCOPE_AGENT) < 4u) { __builtin_amdgcn_s_sleep(1); if (++sp > (1u << 22)) break; }
        }
        __syncthreads();
        f32x4 cA[2][2], cB[2][2];
#pragma unroll
        for (int bj = 0; bj < 2; ++bj)
#pragma unroll
            for (int n = 0; n < 2; ++n) { const int c = c0 + bj * 128 + 16 * n; cA[bj][n] = *(const f32x4*)(g + c);
                if (!FINAL) { cA[bj][n] = cA[bj][n] * (*(const f32x4*)(sc + b * 6144 + c) + 1.0f); cB[bj][n] = *(const f32x4*)(sh + b * 6144 + c); } else cB[bj][n] = (f32x4){0.f, 0.f, 0.f, 0.f}; }
#pragma unroll
        for (int ai = 0; ai < 2; ++ai)
#pragma unroll
            for (int m = 0; m < 4; ++m) { const int r = row0 + 128 * ai + 16 * m; const size_t ro = (size_t)r * D + c0;
                const float rstd = __builtin_amdgcn_rsqf(__hip_atomic_load(ss + r, __ATOMIC_RELAXED, __HIP_MEMORY_SCOPE_AGENT) * (1.0f / D) + EPS);
#pragma unroll
                for (int bj = 0; bj < 2; ++bj) { u32x2 hw[2];
#pragma unroll
                    for (int n = 0; n < 2; ++n) { const size_t o = ro + bj * 128 + 16 * n; const f32x4 y = acc[ai][bj][m][n] * rstd * cA[bj][n];
                        if (FINAL) { *(f32x4*)(out + o) = y; hw[n] = (u32x2){0u, 0u}; }
                        else hw[n] = pack4(y + cB[bj][n]); }
                    if (!FINAL) st_pair16(H + ro + bj * 128, hw[0], hw[1], fq); }
                asm volatile("" ::: "memory"); }
    }
};

__device__ __forceinline__ f32x4 shfl4(f32x4 v, int src) { f32x4 o;
#pragma unroll
    for (int j = 0; j < 4; ++j) o[j] = __shfl(v[j], src);
    return o; }
struct EpiConv {
    static constexpr bool PERM = false, AFTER_DRAIN = false;
    bf16_t* ACT; float *HALO, *PART; const float *cw, *cb;
    __device__ __forceinline__ void operator()(AccRef acc, const Unit& u, int wr, int wc, int fr_, int fq_) const {
        int ln_ = threadIdx.x & 63; asm volatile("" : "+v"(ln_)); const int fr = ln_ & 15, fq = ln_ >> 4; (void)fr_; (void)fq_;
        const int lane = fq * 16 + fr, s1 = fq * 16 + ((fr + 15) & 15), s2 = fq * 16 + ((fr + 14) & 15);
#pragma unroll
        for (int ai = 0; ai < 2; ++ai) { const int grp = 4 * u.pm + 2 * ai + wr, r0 = 64 * grp + fr; u32x2 aw0[4];
#pragma unroll
            for (int n = 0; n < 2; ++n) { const int ng = 128 * u.pn + 32 * wc + 16 * n + 4 * fq;
                const f32x4 wg0 = *(const f32x4*)(cw + ng), wg1 = *(const f32x4*)(cw + NUP + ng), wg2 = *(const f32x4*)(cw + 2 * NUP + ng), bg = *(const f32x4*)(cb + ng);
                const f32x4 wv0 = *(const f32x4*)(cw + DFF + ng), wv1 = *(const f32x4*)(cw + NUP + DFF + ng), wv2 = *(const f32x4*)(cw + 2 * NUP + DFF + ng), bv = *(const f32x4*)(cb + DFF + ng);
                f32x4 pg1 = (f32x4){0.f, 0.f, 0.f, 0.f}, pg2 = pg1, pv1 = pg1, pv2 = pg1;
#pragma unroll
                for (int m = 0; m < 4; ++m) { const f32x4 G = acc[ai][0][m][n], V = acc[ai][1][m][n];
                    const f32x4 g1 = shfl4(G, s1), g2 = shfl4(G, s2), v1 = shfl4(V, s1), v2 = shfl4(V, s2);
                    const f32x4 gm1 = fr >= 1 ? g1 : pg1, gm2 = fr >= 2 ? g2 : pg2, vm1 = fr >= 1 ? v1 : pv1, vm2 = fr >= 2 ? v2 : pv2;
                    const f32x4 cg = bg + wg0 * gm2 + wg1 * gm1 + wg2 * G, cv = bv + wv0 * vm2 + wv1 * vm1 + wv2 * V;
                    const int r = r0 + 16 * m;
                    if (m == 0 && fr < 2) { *(f32x4*)(PART + ((size_t)grp * 2 + fr) * NUP + ng) = cg; *(f32x4*)(PART + ((size_t)grp * 2 + fr) * NUP + DFF + ng) = cv; }
                    { f32x4 a;
#pragma unroll
                        for (int j = 0; j < 4; ++j) a[j] = siluf_(cg[j]) * cv[j];
                        if (n == 0) { aw0[m] = pack4(a); asm volatile("" : "+v"(aw0[m].x), "+v"(aw0[m].y)); }
                        else st_pair16_if(ACT + (size_t)r * DFF + ng - 16, aw0[m], pack4(a), fq, !(m == 0 && fr < 2)); }
                    if (m == 3 && fr >= 14) { *(f32x4*)(HALO + ((size_t)grp * 2 + (fr - 14)) * NUP + ng) = G; *(f32x4*)(HALO + ((size_t)grp * 2 + (fr - 14)) * NUP + DFF + ng) = V; }
                    pg1 = g1; pg2 = g2; pv1 = v1; pv2 = v2;
                    asm volatile("" ::: "memory"); }
                (void)lane; } }
    }
};

__device__ __forceinline__ int crow(int r, int hi) { return (r & 3) + 8 * (r >> 2) + 4 * hi; }
constexpr int VSTR = 264, ATT_VOFF = 2 * 128 * 208;
template <int NCH> struct AttLoader { const bf16_t* ksrc[3]; size_t kstp[3]; int kdst[3]; bool kact[3]; const bf16_t* vsrc[2]; int vdst[2]; };
template <int NCH> __device__ __forceinline__ void att_load(const AttLoader<NCH>& L, int it, u32x4 (&kr)[3], u32x4 (&vr)[2]) {
#pragma unroll
    for (int i = 0; i < 3; ++i) if (L.kact[i]) kr[i] = *(const u32x4*)(L.ksrc[i] + (size_t)it * L.kstp[i]);
#pragma unroll
    for (int i = 0; i < 2; ++i) vr[i] = *(const u32x4*)(L.vsrc[i] + (size_t)it * 128);
}
template <int NCH, int KSTR> __device__ __forceinline__ void att_write(LAS unsigned char* lds, const AttLoader<NCH>& L, int buf, const u32x4 (&kr)[3], const u32x4 (&vr)[2]) {
#pragma unroll
    for (int i = 0; i < 3; ++i) if (L.kact[i]) *(LAS u32x4*)(lds + buf * (128 * KSTR) + L.kdst[i]) = kr[i];
#pragma unroll
    for (int i = 0; i < 2; ++i) { *(LAS u32x2*)(lds + L.vdst[i] + buf * (64 * VSTR)) = (u32x2){vr[i].x, vr[i].y}; *(LAS u32x2*)(lds + L.vdst[i] + buf * (64 * VSTR) + 8) = (u32x2){vr[i].z, vr[i].w}; }
}
struct AttState { f32x16 o0, o1, negm; float mref, lrun; };
template <int NSTEP, int KSTR> __device__ __forceinline__ void att_compute(LAS unsigned char* lds, int it, int buf, bool first, int wq0, int qrow, int r32, int hi, const bf16x8 (&qf)[NSTEP], AttState& S) {
    const LAS unsigned char* kbuf = lds + buf * (128 * KSTR);
#pragma unroll
    for (int s = 0; s < 2; ++s) { if ((128 * it + 64 * s) <= wq0 + 31) {
        f32x16 p[2];
        {
            bf16x8 kf[2][NSTEP];
#pragma unroll
            for (int hh = 0; hh < 2; ++hh)
#pragma unroll
                for (int d0 = 0; d0 < NSTEP; ++d0) kf[hh][d0] = *(const LAS bf16x8*)(kbuf + (64 * s + 32 * hh + r32) * KSTR + d0 * 32 + hi * 16);
            __builtin_amdgcn_sched_barrier(0);
            if (NSTEP == 5) { if (hi) { kf[0][4] = (bf16x8){0, 0, 0, 0, 0, 0, 0, 0}; kf[1][4] = (bf16x8){0, 0, 0, 0, 0, 0, 0, 0}; } }
            f32x16 a0 = S.negm, a1 = S.negm;
#pragma unroll
            for (int d0 = 0; d0 < NSTEP; ++d0) { a0 = __builtin_amdgcn_mfma_f32_32x32x16_bf16(kf[0][d0], qf[d0], a0, 0, 0, 0); a1 = __builtin_amdgcn_mfma_f32_32x32x16_bf16(kf[1][d0], qf[d0], a1, 0, 0, 0); }
            p[0] = a0; p[1] = a1; }
        const int kv0 = 128 * it + 64 * s;
        if (kv0 + 63 > wq0) {
#pragma unroll
            for (int hh = 0; hh < 2; ++hh)
#pragma unroll
                for (int r = 0; r < 16; ++r) { const int kvg = kv0 + 32 * hh + crow(r, hi); if (kvg > qrow) p[hh][r] = -INFINITY; }
        }
        float mx = fmaxf(fmaxf(p[0][0], p[1][0]), fmaxf(p[0][1], p[1][1]));
#pragma unroll
        for (int r = 2; r < 16; r += 2) mx = fmaxf(fmaxf(mx, p[0][r]), fmaxf(fmaxf(p[1][r], p[0][r + 1]), p[1][r + 1]));
        mx = fmaxf(mx, __shfl_xor(mx, 32));
        if ((first && s == 0) || __any(mx > 24.0f)) {
            const float delta = (first && s == 0) ? mx : fmaxf(mx, 0.f), sc = __builtin_amdgcn_exp2f(-delta);
            S.mref += delta; S.lrun *= sc;
#pragma unroll
            for (int r = 0; r < 16; ++r) { S.o0[r] *= sc; S.o1[r] *= sc; p[0][r] -= delta; p[1][r] -= delta; S.negm[r] = -S.mref; }
        }
        const LAS unsigned char* vb = lds + ATT_VOFF + buf * (64 * VSTR) + r32 * VSTR + s * 128 + hi * 8;
        u32x2 vf[2][4][2];
#pragma unroll
        for (int db = 0; db < 2; ++db)
#pragma unroll
            for (int j = 0; j < 4; ++j) { vf[db][j][0] = *(const LAS u32x2*)(vb + db * 32 * VSTR + j * 32); vf[db][j][1] = *(const LAS u32x2*)(vb + db * 32 * VSTR + j * 32 + 16); }
        __builtin_amdgcn_sched_barrier(0);
        float rs0 = 0.f, rs1 = 0.f;
#pragma unroll
        for (int r = 0; r < 16; ++r) { const float e0 = __builtin_amdgcn_exp2f(p[0][r]), e1 = __builtin_amdgcn_exp2f(p[1][r]); p[0][r] = e0; p[1][r] = e1; rs0 += e0; rs1 += e1; }
        S.lrun += rs0 + rs1;
        bf16x8 pb[4];
#pragma unroll
        for (int j = 0; j < 4; ++j) { const int hh = j >> 1, rb = 8 * (j & 1);
            const unsigned w0 = cvt_pk_bf16(p[hh][rb + 0], p[hh][rb + 1]), w1 = cvt_pk_bf16(p[hh][rb + 2], p[hh][rb + 3]), w2 = cvt_pk_bf16(p[hh][rb + 4], p[hh][rb + 5]), w3 = cvt_pk_bf16(p[hh][rb + 6], p[hh][rb + 7]);
            pb[j] = __builtin_bit_cast(bf16x8, (u32x4){w0, w1, w2, w3}); }
#pragma unroll
        for (int j = 0; j < 4; ++j) {
            S.o0 = __builtin_amdgcn_mfma_f32_32x32x16_bf16(__builtin_bit_cast(bf16x8, (u32x4){vf[0][j][0].x, vf[0][j][0].y, vf[0][j][1].x, vf[0][j][1].y}), pb[j], S.o0, 0, 0, 0);
            S.o1 = __builtin_amdgcn_mfma_f32_32x32x16_bf16(__builtin_bit_cast(bf16x8, (u32x4){vf[1][j][0].x, vf[1][j][0].y, vf[1][j][1].x, vf[1][j][1].y}), pb[j], S.o1, 0, 0, 0); }
    } }
}
template <int NSTEP, int NCH, int KSTR>
__device__ __forceinline__ void attn_unit(LAS unsigned char* lds, int b, int h, int qb, const bf16_t* Qp, int qld, int qcol,
                                          const bf16_t* K1, int k1ld, int k1col, const bf16_t* K2, int k2ld, int k2col, const bf16_t* Vt, int vrow0, bf16_t* O, int ocol, int it0) {
    int tid_ = threadIdx.x; asm volatile("" : "+v"(tid_));
    const int tid = tid_, lane = tid & 63, r32 = lane & 31, hi = lane >> 5, wid = __builtin_amdgcn_readfirstlane(tid >> 6);
    const size_t rowbase = (size_t)b * SEQ;
    const int qrow = 256 * qb + 32 * wid + r32;
    bf16x8 qf[NSTEP];
#pragma unroll
    for (int d0 = 0; d0 < (NSTEP == 6 ? 6 : 4); ++d0) qf[d0] = *(const bf16x8*)(Qp + (rowbase + qrow) * qld + qcol + 16 * d0 + 8 * hi);
    if (NSTEP == 5) { const short one = hi ? (short)0 : (short)0x3F80; qf[NSTEP - 1] = (bf16x8){one, one, one, 0, 0, 0, 0, 0}; }
    AttLoader<NCH> L;
#pragma unroll
    for (int i = 0; i < 3; ++i) { const int idx = tid + 512 * i; L.kact[i] = idx < 128 * NCH; const int row = idx / NCH, c = idx % NCH;
        L.ksrc[i] = c < 8 ? K1 + (rowbase + row) * k1ld + k1col + 8 * c : K2 + (rowbase + row) * k2ld + k2col + 8 * (c - 8);
        L.kstp[i] = (size_t)128 * (c < 8 ? k1ld : k2ld); L.kdst[i] = row * KSTR + c * 16; }
#pragma unroll
    for (int i = 0; i < 2; ++i) { const int idx = tid + 512 * i, d = idx >> 4, c = idx & 15; L.vsrc[i] = Vt + (size_t)(vrow0 + d) * T + rowbase + 8 * c; L.vdst[i] = ATT_VOFF + d * VSTR + c * 16; }
    const int NIT = 2 * qb + 2;
    u32x4 kA[3], vA[2], kB[3], vB[2];
    att_load<NCH>(L, it0, kA, vA); att_write<NCH, KSTR>(lds, L, 0, kA, vA);
    att_load<NCH>(L, it0 + 1, kB, vB);
    __syncthreads();
    AttState S; S.o0 = f32x16{}; S.o1 = f32x16{}; S.negm = f32x16{}; S.mref = 0.f; S.lrun = 0.f;
    const int wq0 = 256 * qb + 32 * wid;
    for (int it = it0; it < NIT; it += 2) {
        if (it + 2 < NIT) att_load<NCH>(L, it + 2, kA, vA);
        att_compute<NSTEP, KSTR>(lds, it, 0, it == it0, wq0, qrow, r32, hi, qf, S);
        att_write<NCH, KSTR>(lds, L, 1, kB, vB);
        __syncthreads();
        if (it + 3 < NIT) att_load<NCH>(L, it + 3, kB, vB);
        att_compute<NSTEP, KSTR>(lds, it + 1, 1, false, wq0, qrow, r32, hi, qf, S);
        if (it + 2 < NIT) att_write<NCH, KSTR>(lds, L, 0, kA, vA);
        __syncthreads();
    }
    float lrun = S.lrun; lrun += __shfl_xor(lrun, 32);
    const float inv = 1.0f / lrun;
    bf16_t* op = O + (rowbase + qrow) * 512 + ocol + 8 * hi;
#pragma unroll
    for (int k = 0; k < 2; ++k) {
        const u32x2 a0 = pack4((f32x4){S.o0[8 * k], S.o0[8 * k + 1], S.o0[8 * k + 2], S.o0[8 * k + 3]} * inv), a1 = pack4((f32x4){S.o0[8 * k + 4], S.o0[8 * k + 5], S.o0[8 * k + 6], S.o0[8 * k + 7]} * inv);
        const u32x2 b0 = pack4((f32x4){S.o1[8 * k], S.o1[8 * k + 1], S.o1[8 * k + 2], S.o1[8 * k + 3]} * inv), b1 = pack4((f32x4){S.o1[8 * k + 4], S.o1[8 * k + 5], S.o1[8 * k + 6], S.o1[8 * k + 7]} * inv);
        const auto ax = __builtin_amdgcn_permlane32_swap(a0.x, a1.x, false, false), ay = __builtin_amdgcn_permlane32_swap(a0.y, a1.y, false, false);
        const auto bx = __builtin_amdgcn_permlane32_swap(b0.x, b1.x, false, false), by = __builtin_amdgcn_permlane32_swap(b0.y, b1.y, false, false);
        *(u32x4*)(op + 16 * k) = (u32x4){ax[0], ay[0], ax[1], ay[1]};
        *(u32x4*)(op + 32 + 16 * k) = (u32x4){bx[0], by[0], bx[1], by[1]}; }
}

#define XB_TMO      128
#define XB_XCNT(j)  (256  + 64 * (j))
#define XB_XSUB(j)  (1280 + 64 * (j))
#define XB_XGEN(j)  (2304 + 64 * (j))
#define XB_TOP      3328
#define XB_TOPGEN   3392
#define XCD_BAR_WORDS 3456
#define XB_SPIN_CAP (1u << 18)

__device__ __forceinline__ unsigned xb_ld(unsigned* p)              { return __hip_atomic_load(p, __ATOMIC_RELAXED, __HIP_MEMORY_SCOPE_AGENT); }
__device__ __forceinline__ unsigned xb_add(unsigned* p, unsigned v) { return __hip_atomic_fetch_add(p, v, __ATOMIC_RELAXED, __HIP_MEMORY_SCOPE_AGENT); }
__device__ __forceinline__ unsigned xb_xcc_id() { return (unsigned)__builtin_amdgcn_s_getreg((3 << 11) | 20) & 0xFu; }
#define XB_SPIN(cond, bar) do { unsigned _sp = 0; while (cond) { __builtin_amdgcn_s_sleep(1); \
    if ((++_sp & 255u) == 0u) { if (xb_ld(&(bar)[XB_TMO])) break; if (_sp > XB_SPIN_CAP) { atomicAdd(&(bar)[XB_TMO], 1u); break; } } } } while (0)

struct XcdBarrier {
    unsigned* bar; unsigned x;
    volatile LAS unsigned* st;
};

__device__ __forceinline__ XcdBarrier xcd_barrier_post(unsigned* bar, volatile LAS unsigned* st) {
    XcdBarrier b; b.bar = bar; b.x = xb_xcc_id(); b.st = st;
    if (threadIdx.x == 0) (void)xb_add(&bar[XB_XCNT(b.x)], 1u);
    return b;
}
__device__ __forceinline__ void xcd_barrier_complete(unsigned* bar, unsigned x, unsigned& nloc, unsigned& nx) {
    const unsigned G = gridDim.x * gridDim.y * gridDim.z;
    unsigned sum, cnt, mine, sp = 0u;
    for (;;) {
        sum = 0u; cnt = 0u; mine = 0u;
#pragma unroll
        for (unsigned j = 0; j < 16; ++j) { const unsigned c = xb_ld(&bar[XB_XCNT(j)]); sum += c; cnt += (c > 0u) ? 1u : 0u; mine = (j == x) ? c : mine; }
        if (sum == G) break;
        __builtin_amdgcn_s_sleep(1);
        if ((++sp & 255u) == 0u) { if (xb_ld(&bar[XB_TMO])) break; if (sp > XB_SPIN_CAP) { atomicAdd(&bar[XB_TMO], 1u); break; } }
    }
    nloc = mine > 0u ? mine : 1u; nx = cnt > 0u ? cnt : 1u;
}

__device__ __forceinline__ void xcd_barrier(const XcdBarrier& b) {
    asm volatile("s_waitcnt vmcnt(0)" ::: "memory");
    __syncthreads();
    if (threadIdx.x == 0) {
        unsigned* bar = b.bar;
        __builtin_amdgcn_s_waitcnt(0);
        unsigned nloc = b.st[0], nx = b.st[1];
        if (nloc == 0u) { xcd_barrier_complete(bar, b.x, nloc, nx); b.st[0] = nloc; b.st[1] = nx; }
        const unsigned old = xb_add(&bar[XB_XSUB(b.x)], 1u);
        const unsigned gen = old / nloc;
        if (old + 1u == (gen + 1u) * nloc) {
            __builtin_amdgcn_fence(__ATOMIC_RELEASE, "agent");
            asm volatile("s_waitcnt vmcnt(0)" ::: "memory");
            const unsigned og = xb_add(&bar[XB_TOP], 1u);
            const unsigned tg = og / nx;
            if (og + 1u == (tg + 1u) * nx) xb_add(&bar[XB_TOPGEN], 1u);
            else XB_SPIN(xb_ld(&bar[XB_TOPGEN]) == tg, bar);
            __builtin_amdgcn_fence(__ATOMIC_ACQUIRE, "agent");
            xb_add(&bar[XB_XGEN(b.x)], 1u);
            asm volatile("s_waitcnt vmcnt(0)" ::: "memory");
        } else {
            XB_SPIN(xb_ld(&bar[XB_XGEN(b.x)]) == gen, bar);
            __builtin_amdgcn_fence(__ATOMIC_ACQUIRE, "agent");
            asm volatile("s_waitcnt vmcnt(0)" ::: "memory");
        }
    }
    __syncthreads();
}

struct Args { const void* in[21]; float* out; unsigned char* ws; int ph_lo, ph_hi; };
constexpr int NPH = 12;

__device__ __forceinline__ void transpose_item(const float* W, int ldw, int k0, int sc0, int nvalid, const float* kscale, bf16_t* WT, int K, int drow0, LAS float* scr, int lane) {
    const int c4 = lane & 7, r8 = lane >> 3;
#pragma unroll
    for (int i = 0; i < 8; ++i) { const int kk = 8 * i + r8; f32x4 v = (f32x4){0.f, 0.f, 0.f, 0.f};
        if (4 * c4 < nvalid) { v = *(const f32x4*)(W + (size_t)(k0 + kk) * ldw + sc0 + 4 * c4); if (kscale) v = v * kscale[k0 + kk]; }
        LAS float* sp = scr + kk * 33 + 4 * c4; sp[0] = v[0]; sp[1] = v[1]; sp[2] = v[2]; sp[3] = v[3]; }
    asm volatile("s_waitcnt lgkmcnt(0)" ::: "memory");
    const int c = lane & 7;
#pragma unroll
    for (int j = 0; j < 4; ++j) { const int n = (lane >> 3) + 8 * j; const LAS float* s = scr + (8 * c) * 33 + n;
        u32x4 o; o.x = cvt_pk_bf16(s[0 * 33], s[1 * 33]); o.y = cvt_pk_bf16(s[2 * 33], s[3 * 33]); o.z = cvt_pk_bf16(s[4 * 33], s[5 * 33]); o.w = cvt_pk_bf16(s[6 * 33], s[7 * 33]);
        *(u32x4*)(WT + (size_t)(drow0 + n) * K + k0 + 8 * c) = o; }
    asm volatile("s_waitcnt lgkmcnt(0)" ::: "memory");
}
__device__ __forceinline__ void win_map(int d0, int& sc0, int& nv) {
    nv = 32;
    if (d0 < 384) sc0 = d0; else if (d0 < 416) sc0 = 640 + (d0 - 384); else if (d0 < 448) { sc0 = 2208; nv = 8; } else if (d0 < 512) { sc0 = 0; nv = 0; }
    else if (d0 < 768) sc0 = 384 + (d0 - 512); else if (d0 < 1280) sc0 = 672 + (d0 - 768); else if (d0 < 1792) sc0 = 1184 + (d0 - 1280);
    else if (d0 < 2816) sc0 = 2216 + (d0 - 1792); else if (d0 < 3840) sc0 = 3240 + (d0 - 2816); else sc0 = 1696 + (d0 - 3840);
}

template <int NR> __device__ __forceinline__ void modnorm_rows(const float* xrow, bf16_t* orow, const float* g, const float* sc, const float* sh, int lane, size_t rstride) {
    f32x4 v[NR][4]; float s[NR];
#pragma unroll
    for (int q = 0; q < NR; ++q)
#pragma unroll
        for (int j = 0; j < 4; ++j) v[q][j] = *((const f32x4*)(xrow + q * rstride) + lane + 64 * j);
#pragma unroll
    for (int q = 0; q < NR; ++q) { s[q] = 0.f;
#pragma unroll
        for (int j = 0; j < 4; ++j) s[q] += (v[q][j][0] * v[q][j][0] + v[q][j][1] * v[q][j][1]) + (v[q][j][2] * v[q][j][2] + v[q][j][3] * v[q][j][3]); }
#pragma unroll
    for (int q = 0; q < NR; ++q) { const float rstd = __builtin_amdgcn_rsqf(wave_sum(s[q]) * (1.0f / D) + EPS);
#pragma unroll
        for (int j = 0; j < 4; ++j) { const int c = 4 * (lane + 64 * j); const f32x4 gg = *(const f32x4*)(g + c), ss = *(const f32x4*)(sc + c), hh = *(const f32x4*)(sh + c);
            const f32x4 y = (v[q][j] * rstd * gg) * (ss + 1.0f) + hh; *(u32x2*)(orow + q * rstride + c) = pack4(y); } }
}
template <int NR> __device__ __forceinline__ void modnorm_rows_c(const float* xrow, bf16_t* orow, const f32x4 (&cA)[4], const f32x4 (&cB)[4], int lane, size_t rstride) {
    f32x4 v[NR][4]; float s[NR];
#pragma unroll
    for (int q = 0; q < NR; ++q)
#pragma unroll
        for (int j = 0; j < 4; ++j) v[q][j] = *((const f32x4*)(xrow + q * rstride) + lane + 64 * j);
#pragma unroll
    for (int q = 0; q < NR; ++q) { s[q] = 0.f;
#pragma unroll
        for (int j = 0; j < 4; ++j) s[q] += (v[q][j][0] * v[q][j][0] + v[q][j][1] * v[q][j][1]) + (v[q][j][2] * v[q][j][2] + v[q][j][3] * v[q][j][3]); }
#pragma unroll
    for (int q = 0; q < NR; ++q) { const float rstd = __builtin_amdgcn_rsqf(wave_sum(s[q]) * (1.0f / D) + EPS);
#pragma unroll
        for (int j = 0; j < 4; ++j) *(u32x2*)(orow + q * rstride + 4 * (lane + 64 * j)) = pack4(v[q][j] * rstd * cA[j] + cB[j]); }
}

template <unsigned MASK> __global__ void __launch_bounds__(NTHR, 2) mk_fwd(Args args) {
    extern __shared__ __attribute__((aligned(16))) unsigned char lds_raw[];
    LAS unsigned char* lds = (LAS unsigned char*)lds_raw;
    cg::grid_group grid = cg::this_grid();
    const int tid = threadIdx.x, lane = tid & 63, wave = __builtin_amdgcn_readfirstlane(tid >> 6);
    const int G = gridDim.x, bid = blockIdx.x;
    const int gw = bid * NWAVES + wave, NGW = G * NWAVES;
    unsigned char* ws = args.ws;
    const float* x = (const float*)args.in[0]; const float* cvec = (const float*)args.in[1]; const int* positions = (const int*)args.in[2];
    const float* w_ada = (const float*)args.in[3]; const float* b_ada = (const float*)args.in[4]; const float* norm_mix_g = (const float*)args.in[5];
    const float* w_in = (const float*)args.in[6]; const float* q_norm_g = (const float*)args.in[7]; const float* w_uq = (const float*)args.in[8];
    const float* kv_norm_g = (const float*)args.in[9]; const float* w_ukv = (const float*)args.in[10]; const float* b_forget = (const float*)args.in[11];
    const float* w_o_mla = (const float*)args.in[12]; const float* w_o_fox = (const float*)args.in[13]; const float* w_out = (const float*)args.in[14];
    const float* norm_ffn_g = (const float*)args.in[15]; const float* w_up = (const float*)args.in[16]; const float* conv_w = (const float*)args.in[17];
    const float* conv_b = (const float*)args.in[18]; const float* w_down = (const float*)args.in[19]; const float* norm_final_g = (const float*)args.in[20];
    float* out = args.out;
    bf16_t *Win_t = (bf16_t*)(ws + WS_WIN), *Wuq_t = (bf16_t*)(ws + WS_WUQ), *Wukv_t = (bf16_t*)(ws + WS_WUKV), *Wom_t = (bf16_t*)(ws + WS_WOM), *Wof_t = (bf16_t*)(ws + WS_WOF),
           *Wout_t = (bf16_t*)(ws + WS_WOUT), *Wup_t = (bf16_t*)(ws + WS_WUP), *Wdn_t = (bf16_t*)(ws + WS_WDN);
    bf16_t *HA = (bf16_t*)(ws + WS_HA), *CQ = (bf16_t*)(ws + WS_CQ), *CKV = (bf16_t*)(ws + WS_CKV), *KR = (bf16_t*)(ws + WS_KR), *FB = (bf16_t*)(ws + WS_FB),
           *FQ = (bf16_t*)(ws + WS_FQ), *FK = (bf16_t*)(ws + WS_FK), *FVt = (bf16_t*)(ws + WS_FVT), *GM = (bf16_t*)(ws + WS_GM), *GF = (bf16_t*)(ws + WS_GF),
           *KN = (bf16_t*)(ws + WS_KN), *VMt = (bf16_t*)(ws + WS_VMT), *OM = (bf16_t*)(ws + WS_OM), *OF = (bf16_t*)(ws + WS_OF), *Qb = (bf16_t*)(ws + WS_Q),
           *T1 = (bf16_t*)(ws + WS_T1), *H2 = (bf16_t*)(ws + WS_H2), *Y = (bf16_t*)(ws + WS_Y), *ACT = (bf16_t*)(ws + WS_ACT);
    float *ADA = (float*)(ws + WS_ADA), *SSQ = (float*)(ws + WS_SSQ), *SSK = (float*)(ws + WS_SSK), *CS = (float*)(ws + WS_CS), *LF = (float*)(ws + WS_LF),
          *HALO = (float*)(ws + WS_HALO), *PART = (float*)(ws + WS_PART), *NF = (float*)(ws + WS_NF), *NRM = (float*)(ws + WS_NRM);
    const int lo = args.ph_lo, hi = args.ph_hi & 0xff, sub = args.ph_hi >> 8;
    const bool fusednorm = (G == 256) && (hi - lo > 1);
#define IN(k) (((MASK >> (k)) & 1u) && lo <= (k) && (k) < hi)
    volatile LAS unsigned* bst = (volatile LAS unsigned*)(lds + 131072 + 64);
    XcdBarrier xbar; xbar.bar = (unsigned*)(ws + WS_BAR); xbar.x = 0; xbar.st = bst;
    if (hi - lo > 1) { if (tid == 0) { bst[0] = 0u; bst[1] = 0u; } __syncthreads(); xbar = xcd_barrier_post((unsigned*)(ws + WS_BAR), bst); }
#define SEAM(k) do { if (IN(k) && IN((k) + 1)) { if (args.ph_hi > 0xFFFF) grid.sync();   xcd_barrier(xbar); } } while (0)

    if (IN(0)) {
#pragma unroll 1
      for (int mprep = 0; mprep < MP_REPS; ++mprep) {
        LAS float* sl = (LAS float*)lds;
        for (int i = tid; i < 2 * D; i += NTHR) sl[i] = siluf_(cvec[i]);
        __syncthreads();
        for (int cgp = bid; cgp < 192; cgp += G) {
            const int c4 = lane & 7, ks = lane >> 3; f32x4 a0 = (f32x4){0.f, 0.f, 0.f, 0.f}, a1 = a0;
#pragma unroll
            for (int i = 0; i < 16; ++i) { const int k = 128 * wave + 8 * i + ks; const f32x4 w = *(const f32x4*)(w_ada + (size_t)k * 6144 + cgp * 32 + 4 * c4); a0 += w * sl[k]; a1 += w * sl[D + k]; }
#pragma unroll
            for (int j = 0; j < 4; ++j) { a0[j] += __shfl_xor(a0[j], 8); a0[j] += __shfl_xor(a0[j], 16); a0[j] += __shfl_xor(a0[j], 32); a1[j] += __shfl_xor(a1[j], 8); a1[j] += __shfl_xor(a1[j], 16); a1[j] += __shfl_xor(a1[j], 32); }
            if (lane < 8) {
#pragma unroll
                for (int j = 0; j < 4; ++j) { sl[2048 + (wave * 2 + 0) * 32 + 4 * lane + j] = a0[j]; sl[2048 + (wave * 2 + 1) * 32 + 4 * lane + j] = a1[j]; } }
            __syncthreads();
            if (tid < 64) { const int bb = tid >> 5, nn = tid & 31; float s = b_ada[cgp * 32 + nn];
#pragma unroll
                for (int w = 0; w < 8; ++w) s += sl[2048 + (w * 2 + bb) * 32 + nn];
                ADA[bb * 6144 + cgp * 32 + nn] = s; }
            __syncthreads();
        }
        __syncthreads();
        for (int i = bid * NTHR + tid; i < T * 16; i += G * NTHR) { const int row = i >> 4, k = i & 15;
            const double rev = (double)positions[row] * INVF[k] * 0.15915494309189535; const double fr = rev - floor(rev);
            const float a = (float)(fr < 0.5 ? fr : fr - 1.0) * 6.283185307179586f;
            CS[i] = __cosf(a); CS[T * 16 + i] = __sinf(a); }
        LAS float* scr = (LAS float*)(lds + 16384 + wave * 8704);
        constexpr int I_IN = (DINP / 32) * 16, I_UQ = 24 * 6, I_UKV = 32 * 4, I_OM = 32 * 8, I_OUT = 32 * 16, I_UP = (NUP / 32) * 16, I_DN = 32 * 44;
        constexpr int NITEMS = I_IN + I_UQ + I_UKV + 2 * I_OM + I_OUT + I_UP + I_DN;
        for (int it = gw; it < NITEMS; it += NGW) {
            int r = it;
            if (r < I_IN) { const int rb = r % (DINP / 32), kb = r / (DINP / 32); int sc0, nv; win_map(32 * rb, sc0, nv); transpose_item(w_in, DIN, 64 * kb, sc0, nv, nullptr, Win_t, D, 32 * rb, scr, lane); continue; } r -= I_IN;
            if (r < I_UQ) { const int rb = r % 24, kb = r / 24; transpose_item(w_uq, 768, 64 * kb, 32 * rb, 32, q_norm_g, Wuq_t, QR, 32 * rb, scr, lane); continue; } r -= I_UQ;
            if (r < I_UKV) { const int rb = r % 32, kb = r / 32; const int d0 = 32 * rb, dd = d0 & 511, sc0 = (dd >> 6) * 128 + (dd & 63) + (d0 >= 512 ? 64 : 0);
                transpose_item(w_ukv, 1024, 64 * kb, sc0, 32, kv_norm_g, Wukv_t, KVR, d0, scr, lane); continue; } r -= I_UKV;
            if (r < I_OM) { const int rb = r % 32, kb = r / 32; transpose_item(w_o_mla, D, 64 * kb, 32 * rb, 32, nullptr, Wom_t, 512, 32 * rb, scr, lane); continue; } r -= I_OM;
            if (r < I_OM) { const int rb = r % 32, kb = r / 32; transpose_item(w_o_fox, D, 64 * kb, 32 * rb, 32, nullptr, Wof_t, 512, 32 * rb, scr, lane); continue; } r -= I_OM;
            if (r < I_OUT) { const int rb = r % 32, kb = r / 32; transpose_item(w_out, D, 64 * kb, 32 * rb, 32, nullptr, Wout_t, D, 32 * rb, scr, lane); continue; } r -= I_OUT;
            if (r < I_UP) { const int rb = r % (NUP / 32), kb = r / (NUP / 32); const int d0 = 32 * rb, tt = d0 >> 8, rr = d0 & 255, sc0 = rr < 128 ? 128 * tt + rr : DFF + 128 * tt + (rr - 128);
                transpose_item(w_up, NUP, 64 * kb, sc0, 32, nullptr, Wup_t, D, d0, scr, lane); continue; } r -= I_UP;
            { const int rb = r % 32, kb = r / 32; transpose_item(w_down, D, 64 * kb, 32 * rb, 32, nullptr, Wdn_t, DFF, 32 * rb, scr, lane); }
        }
          }
    }
    SEAM(0);
    if (IN(1)) {
#pragma unroll 1
      for (int mprep = 0; mprep < MP1_REPS; ++mprep) {
        int curb = -1; f32x4 cA[4], cB[4];
        for (int mp = gw; mp < T / 4; mp += NGW) { const int m = 4 * mp, b = m >> 13;
            if (b != curb) { curb = b; const float* ad = ADA + b * 6144;
#pragma unroll
                for (int j = 0; j < 4; ++j) { const int c = 4 * (lane + 64 * j); cA[j] = *(const f32x4*)(norm_mix_g + c) * (*(const f32x4*)(ad + 1024 + c) + 1.0f); cB[j] = *(const f32x4*)(ad + c); } }
            modnorm_rows_c<4>(x + (size_t)m * D, HA + (size_t)m * D, cA, cB, lane, (size_t)D); }
          }
    }
    SEAM(1);
    if (IN(2)) {
        { pg8::Gemm g{HA, Win_t, T, NPROJ, D}; pg8::StaticOrder S; S.init(T, NPROJ, G, bid);
          EpiProj E{CQ, CKV, KR, FQ, FK, GM, GF, LF, SSQ, SSK, CS, b_forget};
#ifdef SINGLE_UNIT
          S.single = 1;
#pragma unroll 1
          for (int rd = 0; rd * G < S.nwg; ++rd) { S.base = rd; pg8::gemm_phase<EpiProj, pg8::StaticOrder, true, true>(lds, g, S, E); }
#else
          pg8::gemm_phase<EpiProj, pg8::StaticOrder, true, true>(lds, g, S, E);
#endif
        }
#ifndef NO_G2
        { pg8::Gemm g{Win_t + (size_t)NPROJ * D, HA, 512, T, D}; pg8::StaticOrder S; S.init(512, T, G, G - 1 - bid);
          EpiVt E{FVt, nullptr, 0.f};
          pg8::gemm_phase<EpiVt, pg8::StaticOrder, true, true>(lds, g, S, E); }
#endif
    }
    SEAM(2);
    if (IN(3)) {
#pragma unroll 1
      for (int smrep = 0; smrep < SM_REPS; ++smrep) {
        {
            float mq0 = 0.f, mq1 = 0.f, mk0 = 0.f, mk1 = 0.f;
            const bool light = G != 256 || (bid >= 192 && bid < 240); const int lw = G != 256 ? gw : (bid - 192) * NWAVES + wave, LNW = G != 256 ? NGW : 48 * NWAVES;
            if (light)
            for (int r0 = lw * 8; r0 < T; r0 += LNW * 8) { u32x4 qv[8], kv[8];
#pragma unroll
                for (int i = 0; i < 8; ++i) { qv[i] = *(const u32x4*)(FQ + (size_t)(r0 + i) * 512 + 8 * lane); kv[i] = *(const u32x4*)(FK + (size_t)(r0 + i) * 512 + 8 * lane); }
                float sq = 0.f, sk = 0.f;
#pragma unroll
                for (int i = 0; i < 8; ++i) { float a = 0.f, c = 0.f;
#pragma unroll
                    for (int w = 0; w < 4; ++w) { const float q0 = bflo(qv[i][w]), q1 = bfhi(qv[i][w]), k0 = bflo(kv[i][w]), k1 = bfhi(kv[i][w]); a += q0 * q0 + q1 * q1; c += k0 * k0 + k1 * k1; }
                    a += __shfl_xor(a, 1); a += __shfl_xor(a, 2); a += __shfl_xor(a, 4); c += __shfl_xor(c, 1); c += __shfl_xor(c, 2); c += __shfl_xor(c, 4);
                    sq = fmaxf(sq, a); sk = fmaxf(sk, c); }
                if (r0 >> 13) { mq1 = fmaxf(mq1, sq); mk1 = fmaxf(mk1, sk); } else { mq0 = fmaxf(mq0, sq); mk0 = fmaxf(mk0, sk); } }
            if ((lane & 7) == 0) { const int hd = lane >> 3; unsigned* N = (unsigned*)NRM;
                atomicMax(N + hd, __float_as_uint(mq0)); atomicMax(N + 8 + hd, __float_as_uint(mq1)); atomicMax(N + 16 + hd, __float_as_uint(mk0)); atomicMax(N + 24 + hd, __float_as_uint(mk1)); }
        }
#ifndef P3_NO_SCAN
        for (int sq = (G == 256 ? bid - 240 : bid); sq >= 0 && sq < 16; sq += G) {
            const int bb = sq >> 3, hh = sq & 7; LAS double* sd = (LAS double*)lds;
            double v[16]; double run = 0.0;
#pragma unroll
            for (int j = 0; j < 16; ++j) { run += (double)LF[((size_t)bb * SEQ + 16 * tid + j) * 8 + hh]; v[j] = run; }
            sd[tid] = run; __syncthreads();
            if (tid < 64) { double loc[8]; double s = 0.0;
#pragma unroll
                for (int j = 0; j < 8; ++j) { s += sd[tid * 8 + j]; loc[j] = s; }
                double incl = s;
#pragma unroll
                for (int o = 1; o < 64; o <<= 1) { const double up = __shfl_up(incl, o); if (lane >= o) incl += up; }
                const double excl = incl - s;
#pragma unroll
                for (int j = 0; j < 8; ++j) sd[512 + tid * 8 + j] = excl + loc[j]; }
            __syncthreads();
            const double off = tid ? sd[512 + tid - 1] : 0.0;
#pragma unroll
            for (int j = 0; j < 16; ++j) { const double val = -(v[j] + off) * 1.4426950408889634;
                const float f1 = (float)val; const unsigned short b1 = f2bf(f1); const double r1 = val - (double)bf2f(b1);
                const unsigned short b2 = f2bf((float)r1); const double r2 = r1 - (double)bf2f(b2); const unsigned short b3 = f2bf((float)r2);
                *(u32x4*)(FB + (((size_t)bb * SEQ + 16 * tid + j) * 8 + hh) * 8) = (u32x4){(unsigned)b1 | ((unsigned)b2 << 16), (unsigned)b3, 0u, 0u};
                NF[((size_t)bb * SEQ + 16 * tid + j) * 8 + hh] = f1; }
            __syncthreads();
        }
#endif
#ifndef P3_NO_Q
        { pg8::Gemm g{CQ, Wuq_t, T, 768, QR}; pg8::StaticOrder S; S.init(T, 768, G, bid); EpiQ E{Qb, SSQ, CS};
          pg8::gemm_phase<EpiQ, pg8::StaticOrder, true, true>(lds, g, S, E); }
#endif
#ifndef P3_NO_KN
        { pg8::Gemm g{CKV, Wukv_t, T, 512, KVR}; pg8::StaticOrder S; S.init(T, 512, G, (bid + 64) % G); EpiKN E{KN, SSK};
          pg8::gemm_phase<EpiKN, pg8::StaticOrder, true, true>(lds, g, S, E); }
#endif
#ifndef P3_NO_VMT
        { pg8::Gemm g{Wukv_t + (size_t)512 * KVR, CKV, 512, T, KVR}; pg8::StaticOrder S; S.init(512, T, G, (bid + G - 64) % G); EpiVt E{VMt, SSK, 1.0f / KVR};
          pg8::gemm_phase<EpiVt, pg8::StaticOrder, true, true>(lds, g, S, E); }
#endif
          }
    }
    SEAM(3);
    if (IN(4)) {
#ifndef ATT_REPS
#define ATT_REPS 1
#endif
        {
            volatile LAS unsigned* slot = (volatile LAS unsigned*)(lds + 131072 + 128);
            if (wave >= 4) __builtin_amdgcn_s_setprio(1);
            unsigned* qctr = (unsigned*)(ws + WS_NRM + 128);
#pragma unroll 1
            for (;;) {
                if (tid == 0) slot[0] = __hip_atomic_fetch_add(qctr, 1u, __ATOMIC_RELAXED, __HIP_MEMORY_SCOPE_AGENT);
                __syncthreads();
                const unsigned un = slot[0];
                __syncthreads();
                if (un >= 1024u) break;
                const int qb = 31 - (int)(un >> 5), w = (int)(un & 31), br = w >> 4, bh = w & 15, bb = bh >> 3, hh = bh & 7;
                if (br == 0) attn_unit<6, 12, 208>(lds, bb, hh, qb, Qb, 768, hh * 96, KN, 512, hh * 64, KR, 32, 0, VMt, hh * 64, OM, hh * 64, 0);
                else {
                    const float bound = 2.02f * sqrtf(NRM[bb * 8 + hh] * NRM[16 + bb * 8 + hh]) + 40.0f, lim = NF[((size_t)bb * SEQ + 256 * qb) * 8 + hh] - bound;
                    const int nit = 2 * qb + 2; const bool skip = lane < nit && NF[((size_t)bb * SEQ + 128 * lane + 127) * 8 + hh] <= lim;
                    int it0 = __builtin_amdgcn_readfirstlane(__popcll(__ballot(skip))); it0 = (it0 < nit - 2 ? it0 : nit - 2) & ~1;
                    attn_unit<5, 9, 144>(lds, bb, hh, qb, FQ, 512, hh * 64, FK, 512, hh * 64, FB, 64, hh * 8, FVt, hh * 64, OF, hh * 64, it0); }
                __syncthreads();
            }
            __builtin_amdgcn_s_setprio(0);
        }
    }
    SEAM(4);
    if (IN(5)) {
#pragma unroll 1
      for (int smrep = 0; smrep < SM_REPS; ++smrep) {
        { pg8::Gemm g{OM, Wom_t, T, D, 512}; PairOrder S; S.S0.init(T, D, G, bid); EpiGate2 E{GM, GF, Y};
          pg8::gemm_phase<EpiGate2, PairOrder, true, true>(lds, g, S, E); }

          }
    }
    SEAM(5);
    if (IN(6)) {
#pragma unroll 1
      for (int smrep = 0; smrep < SM_REPS; ++smrep) {
        pg8::Gemm g{Y, Wout_t, T, D, D}; pg8::StaticOrder S; S.init(T, D, G, bid);
        if (fusednorm) { EpiResNorm<false> E{x, out, ADA + 2048, (float*)(ws + WS_SS1), (unsigned*)(ws + WS_CNT), norm_ffn_g, ADA + 4096, ADA + 3072, H2};
            pg8::gemm_phase<EpiResNorm<false>, pg8::StaticOrder, false, true>(lds, g, S, E); }
        else { EpiRes E{x, out, ADA + 2048};
            pg8::gemm_phase<EpiRes, pg8::StaticOrder, true, true>(lds, g, S, E); }
          }
    }
    SEAM(6);
    if (IN(7) && !fusednorm) {
#pragma unroll 1
      for (int mprep = 0; mprep < MP_REPS; ++mprep) {
        for (int mp = gw; mp < T / 2; mp += NGW) { const int m = 2 * mp; const float* ad = ADA + (m >> 13) * 6144; modnorm_rows<2>(out + (size_t)m * D, H2 + (size_t)m * D, norm_ffn_g, ad + 4096, ad + 3072, lane, (size_t)D); }
          }
    }
    if (!fusednorm) SEAM(7);
    if (IN(8)) {
#pragma unroll 1
      for (int rep8 = 0; rep8 < P8_REPS; ++rep8) {
        pg8::Gemm g{H2, Wup_t, T, NUP, D}; pg8::StaticOrder S; S.init(T, NUP, G, bid); EpiConv E{ACT, HALO, PART, conv_w, conv_b};
        pg8::gemm_phase<EpiConv, pg8::StaticOrder, true, true>(lds, g, S, E);
      }
    }
    SEAM(8);
    if (IN(9)) {
        for (int i = bid * NTHR + tid; i < 256 * 2 * (DFF / 4); i += G * NTHR) {
            const int c4 = i % (DFF / 4), rr = (i / (DFF / 4)) & 1, grp = i / (2 * (DFF / 4)), ng = 4 * c4;
            f32x4 cgv = *(const f32x4*)(PART + ((size_t)grp * 2 + rr) * NUP + ng), cvv = *(const f32x4*)(PART + ((size_t)grp * 2 + rr) * NUP + DFF + ng);
            if (grp & 127) {
                const float* H = HALO + (size_t)(grp - 1) * 2 * NUP;
                const f32x4 wg0 = *(const f32x4*)(conv_w + ng), wg1 = *(const f32x4*)(conv_w + NUP + ng), wv0 = *(const f32x4*)(conv_w + DFF + ng), wv1 = *(const f32x4*)(conv_w + NUP + DFF + ng);
                const f32x4 hg0 = *(const f32x4*)(H + ng), hg1 = *(const f32x4*)(H + NUP + ng), hv0 = *(const f32x4*)(H + DFF + ng), hv1 = *(const f32x4*)(H + NUP + DFF + ng);
                if (rr == 0) { cgv += wg0 * hg0 + wg1 * hg1; cvv += wv0 * hv0 + wv1 * hv1; }
                else { cgv += wg0 * hg1; cvv += wv0 * hv1; }
            }
            f32x4 a;
#pragma unroll
            for (int j = 0; j < 4; ++j) a[j] = siluf_(cgv[j]) * cvv[j];
            *(u32x2*)(ACT + (size_t)(64 * grp + rr) * DFF + ng) = pack4(a);
        }
    }
    SEAM(9);
    if (IN(10)) {
        pg8::Gemm g{ACT, Wdn_t, T, D, DFF}; pg8::StaticOrder S; S.init(T, D, G, bid);
        if (fusednorm) { EpiResNorm<true> E{out, out, ADA + 5120, (float*)(ws + WS_SS2), (unsigned*)(ws + WS_CNT) + 64 * 64, norm_final_g, nullptr, nullptr, nullptr};
            pg8::gemm_phase<EpiResNorm<true>, pg8::StaticOrder, false, true>(lds, g, S, E); }
        else { EpiRes E{out, out, ADA + 5120};
            pg8::gemm_phase<EpiRes, pg8::StaticOrder, true, true>(lds, g, S, E); }
    }
    if (!fusednorm) SEAM(10);
    if (IN(11) && !fusednorm) {
        for (int mp = gw; mp < T / 2; mp += NGW) { float* row = out + (size_t)(2 * mp) * D; f32x4 v[2][4]; float s[2];
#pragma unroll
            for (int q = 0; q < 2; ++q)
#pragma unroll
                for (int j = 0; j < 4; ++j) v[q][j] = *((const f32x4*)(row + q * D) + lane + 64 * j);
#pragma unroll
            for (int q = 0; q < 2; ++q) { s[q] = 0.f;
#pragma unroll
                for (int j = 0; j < 4; ++j) s[q] += (v[q][j][0] * v[q][j][0] + v[q][j][1] * v[q][j][1]) + (v[q][j][2] * v[q][j][2] + v[q][j][3] * v[q][j][3]); }
#pragma unroll
            for (int q = 0; q < 2; ++q) { const float rstd = __builtin_amdgcn_rsqf(wave_sum(s[q]) * (1.0f / D) + EPS);
#pragma unroll
                for (int j = 0; j < 4; ++j) { const f32x4 gg = *((const f32x4*)norm_final_g + lane + 64 * j); *((f32x4*)(row + q * D) + lane + 64 * j) = v[q][j] * rstd * gg; } } }
    }
#undef IN
#undef SEAM
}


#ifdef DBG_STOP
__global__ void dump_kernel(float* out, const unsigned short* src, size_t ne, const unsigned short* src2) {
    const size_t N = (size_t)T * D;
    for (size_t i = (size_t)blockIdx.x * blockDim.x + threadIdx.x; i < N; i += (size_t)gridDim.x * blockDim.x)
        out[i] = i < ne ? bf2f(src[i]) : (src2 && i - ne < ne ? bf2f(src2[i - ne]) : 0.f);
}
#endif
#ifndef MK_ONE_LAUNCH
#define MK_ONE_LAUNCH 1
#endif
extern "C" void kernel_launch(void* const* d_in, const int* in_sizes, int n_in, void* d_out, int out_size, void* d_ws, size_t ws_size, hipStream_t stream) {
    static int grid = 0;
    const void* kfn = (const void*)mk_fwd<0xFFFu>;
    if (grid == 0) {
        int dev = 0, cus = 0, per_cu = 0;
        (void)hipGetDevice(&dev); (void)hipDeviceGetAttribute(&cus, hipDeviceAttributeMultiprocessorCount, dev);
        if (hipFuncSetAttribute(kfn, hipFuncAttributeMaxDynamicSharedMemorySize, LDS_BYTES) != hipSuccess) { fprintf(stderr, "hipFuncSetAttribute failed\n"); grid = -1; return; }
        if (hipOccupancyMaxActiveBlocksPerMultiprocessor(&per_cu, kfn, NTHR, LDS_BYTES) != hipSuccess || per_cu < 1) { fprintf(stderr, "occupancy query: %d\n", per_cu); per_cu = 1; }
        (void)hipGetLastError();
        grid = cus * per_cu;
        fprintf(stderr, "mk_fwd: grid %d (cus %d x %d), ws %zu\n", grid, cus, per_cu, ws_size);
    }
    if (grid < 0) return;
    (void)hipMemsetAsync((unsigned char*)d_ws + ZERO_OFF, 0, ZERO_BYTES, stream);
    Args a{};
    for (int i = 0; i < 21; ++i) a.in[i] = d_in[i];
    a.out = (float*)d_out; a.ws = (unsigned char*)d_ws;
#if MK_ONE_LAUNCH
    a.ph_lo = 0; a.ph_hi = NPH;
    void* kargs[] = {&a};
    hipError_t e = hipLaunchCooperativeKernel(kfn, dim3(grid), dim3(NTHR), kargs, LDS_BYTES, stream);
    if (e != hipSuccess) fprintf(stderr, "cooperative launch failed: %s (grid %d)\n", hipGetErrorString(e), grid);
#else
#define MK_L(ph) do { a.ph_lo = ph; a.ph_hi = ph + 1; (void)hipFuncSetAttribute((const void*)mk_fwd<(1u << ph)>, hipFuncAttributeMaxDynamicSharedMemorySize, LDS_BYTES); hipLaunchKernelGGL(mk_fwd<(1u << ph)>, dim3(grid), dim3(NTHR), LDS_BYTES, stream, a); } while (0)
#ifdef DBG_STOP
#define MK_LD(ph) do { if (ph < DBG_STOP) MK_L(ph); } while (0)
#ifdef P5_ONLY_G7
#define P5_ONLY 1
#else
#define P5_ONLY 0
#endif
#ifdef P5_SPLIT
#undef MK_LD
#define MK_LD(ph) do { if (ph < DBG_STOP) { if (ph == 5) { (void)hipFuncSetAttribute((const void*)mk_fwd<32u>, hipFuncAttributeMaxDynamicSharedMemorySize, LDS_BYTES); a.ph_lo = 5; a.ph_hi = 6 | 0x100; hipLaunchKernelGGL(mk_fwd<32u>, dim3(grid), dim3(NTHR), LDS_BYTES, stream, a); a.ph_hi = 6 | 0x200; if (!P5_ONLY) hipLaunchKernelGGL(mk_fwd<32u>, dim3(grid), dim3(NTHR), LDS_BYTES, stream, a); } else MK_L(ph); } } while (0)
#endif
    MK_LD(0); MK_LD(1); MK_LD(2); MK_LD(3); MK_LD(4); MK_LD(5); MK_LD(6); MK_LD(7); MK_LD(8); MK_LD(9); MK_LD(10); MK_LD(11);
#ifdef DUMP_OFF
    hipLaunchKernelGGL(dump_kernel, dim3(2048), dim3(256), 0, stream, (float*)d_out, (const unsigned short*)((const unsigned char*)d_ws + (size_t)(DUMP_OFF) * MiB), (size_t)(DUMP_MIB) * MiB / 2,
#ifdef DUMP_OFF2
        (const unsigned short*)((const unsigned char*)d_ws + (size_t)(DUMP_OFF2) * MiB));
#else
        (const unsigned short*)nullptr);
#endif
#endif
#else
    MK_L(0); MK_L(1); MK_L(2); MK_L(3); MK_L(4); MK_L(5); MK_L(6); MK_L(7); MK_L(8); MK_L(9); MK_L(10); MK_L(11);
#endif
#undef MK_L
#endif
}
```

```cpp
#include <hip/hip_runtime.h>
#include <hip/hip_cooperative_groups.h>
#include <cstdio>
#include <cstdint>
#include <cmath>
namespace cg = cooperative_groups;
namespace pg8 {
#define PG8_LAS __attribute__((address_space(3)))
typedef unsigned short bf16_t;
typedef short bf16x8 __attribute__((ext_vector_type(8)));
typedef float f32x4 __attribute__((ext_vector_type(4)));
typedef unsigned u32x4 __attribute__((ext_vector_type(4)));
constexpr int BM = 256, BK = 64, HALF = 128, HTB = HALF * BK * 2  , STAGE_BYTES = 8 * HTB, NXCD = 8, WGM = 8;

__host__ __device__ __forceinline__ int lds_byte(int r, int c) { const int st = (r >> 4) * 2 + (c >> 5), rr = r & 15, cc = c & 31, ob = rr * 64 + cc * 2; return st * 1024 + (ob ^ (((ob >> 9) & 1) << 5)); }
__host__ __device__ __forceinline__ void stage_rc(int b, int& R, int& C) { const int st = b / 1024, sb = b % 1024, swz = sb ^ (((sb >> 9) & 1) << 5); R = (st >> 1) * 16 + swz / 64; C = (st & 1) * 32 + (swz % 64) / 2; }
__host__ __device__ __forceinline__ int perm32(int rho) { const int n = rho >> 4, i = rho & 15; return 8 * (i >> 2) + 4 * n + (i & 3); }

struct Unit { int pm, pn; };
struct Gemm { const bf16_t* A; const bf16_t* Bt; int M, N, K; };

struct StaticOrder {
    int nM, nN, nwg, G, c, base = 0, single = 0, off = 0;
    __host__ __device__ void init(int M, int N, int G_, int c_) { nM = M / BM; nN = N / BM; nwg = nM * nN; G = G_; c = c_; }
    __host__ __device__ bool next(int i, Unit& u) const {
        if (single && i > 0) return false;
        const long L = (long)(i + base) * G + c; if (L >= nwg) return false;
        int wgid = (int)L; { const int q = nwg / NXCD, r = nwg % NXCD, xcd = wgid % NXCD, off = wgid / NXCD; wgid = (xcd < r ? xcd * (q + 1) : r * (q + 1) + (xcd - r) * q) + off; }
        wgid += off;
        const int nig = WGM * nN, gid = wgid / nig, fm = gid * WGM, gsz = (nM - fm) < WGM ? (nM - fm) : WGM;
        u.pm = fm + ((wgid % nig) % gsz); u.pn = (wgid % nig) / gsz; return true;
    }
    __device__ __forceinline__ void a_ready(const Unit&) const {}
    __device__ __forceinline__ void done(const Unit&) const {}
};

__device__ __forceinline__ unsigned cvt_pk_bf16(float lo, float hi) { unsigned r; asm volatile("v_cvt_pk_bf16_f32 %0, %1, %2" : "=v"(r) : "v"(lo), "v"(hi)); return r; }
typedef float f32x2 __attribute__((ext_vector_type(2)));
template <class E, class = void> struct epi_keep { static constexpr bool value = false; };
template <class E> struct epi_keep<E, decltype((void)E::KEEP)> { static constexpr bool value = E::KEEP; };
template <class Epi, class Sched, bool ALIGN_EPI = false, bool SP2 = false>
__device__ __forceinline__ void gemm_phase(PG8_LAS unsigned char* lds, const Gemm g, const Sched& S, const Epi& E) {
    int tid_ = threadIdx.x; asm volatile("" : "+v"(tid_));
    const int tid = tid_, wid = __builtin_amdgcn_readfirstlane(tid >> 6), lane = tid & 63, wr = wid >> 2, wc = wid & 3, fr = lane & 15, fq = lane >> 4;
    int K_ = g.K; asm volatile("" : "+s"(K_));
    const int K = K_, nt = K / BK;
    unsigned voffA[2], voffB[2];
#pragma unroll
    for (int i = 0; i < 2; ++i) { int R, C; stage_rc(tid * 16 + i * 8192, R, C); const int Rb = Epi::PERM ? ((R & ~31) + perm32(R & 31)) : R;
        voffA[i] = (unsigned)(R * K + C) * 2u; voffB[i] = (unsigned)(Rb * K + C) * 2u; }
    const size_t kstep = (size_t)(BK * 2);
    const size_t hstep = (size_t)HALF * K * 2;
    const size_t tstep = 2 * hstep;
    const unsigned ldsw = (unsigned)wid * 1024u;
    const int aoff = lds_byte(wr * 64 + fr, fq * 8), boff = lds_byte(wc * 32 + fr, fq * 8);
#define PG8_SA(b, h) (((b) * 2 + (h)) * HTB)
#define PG8_SB(b, h) ((4 + (b) * 2 + (h)) * HTB)
#define PG8_STAGE(bufoff, gbase, voff) do { _Pragma("unroll") for (int _i = 0; _i < 2; ++_i) \
        __builtin_amdgcn_global_load_lds((const unsigned*)((const char*)(gbase) + (voff)[_i]), (PG8_LAS unsigned*)(lds + (bufoff) + ldsw + _i * 8192), 16, 0, 0); } while (0)
#define PG8_LDA(dst, b, h) do { _Pragma("unroll") for (int m = 0; m < 4; ++m) _Pragma("unroll") for (int k = 0; k < 2; ++k) dst[m][k] = *(const PG8_LAS bf16x8*)(lds + PG8_SA(b, h) + aoff + m * 2048 + k * 1024); } while (0)
#define PG8_LDB(dst, b, h) do { _Pragma("unroll") for (int n = 0; n < 2; ++n) _Pragma("unroll") for (int k = 0; k < 2; ++k) dst[n][k] = *(const PG8_LAS bf16x8*)(lds + PG8_SB(b, h) + boff + n * 2048 + k * 1024); } while (0)
#define PG8_MMA(ai, bj, At, Bt) do { __builtin_amdgcn_s_setprio(1); _Pragma("unroll") for (int m = 0; m < 4; ++m) _Pragma("unroll") for (int n = 0; n < 2; ++n) _Pragma("unroll") for (int k = 0; k < 2; ++k) \
        acc[ai][bj][m][n] = __builtin_amdgcn_mfma_f32_16x16x32_bf16(Bt[n][k], At[m][k], acc[ai][bj][m][n], 0, 0, 0); __builtin_amdgcn_s_setprio(0); } while (0)
#define PG8_WAIT_V(n) asm volatile("s_waitcnt vmcnt(" #n ")" ::: "memory")
#define PG8_WAIT_L(n) asm volatile("s_waitcnt lgkmcnt(" #n ")" ::: "memory")
#define PG8_BAR __builtin_amdgcn_s_barrier()
#define PG8_SCHED __builtin_amdgcn_sched_barrier(0)
    Unit cur, nxt; int ui = 0;
    if (!S.next(0, cur)) return;
    f32x4 acc[2][2][4][2];
#pragma unroll
    for (int a = 0; a < 2; ++a)
#pragma unroll
        for (int b = 0; b < 2; ++b)
#pragma unroll
            for (int m = 0; m < 4; ++m)
#pragma unroll
                for (int n = 0; n < 2; ++n) acc[a][b][m][n] = (f32x4){0.f, 0.f, 0.f, 0.f};
    bf16x8 At[4][2], B0[2][2], B1[2][2];
    const char* cA = (const char*)g.A + (size_t)cur.pm * tstep; const char* cB = (const char*)g.Bt + (size_t)cur.pn * tstep;
    S.a_ready(cur);
    if constexpr (SP2) {
        PG8_STAGE(PG8_SB(0, 0), cB, voffB); PG8_STAGE(PG8_SB(0, 1), cB + hstep, voffB); PG8_STAGE(PG8_SA(0, 0), cA, voffA); PG8_STAGE(PG8_SA(0, 1), cA + hstep, voffA);
        if (wr == 1) PG8_BAR;
        PG8_WAIT_V(2); PG8_BAR;
        PG8_STAGE(PG8_SB(1, 0), cB + kstep, voffB); PG8_STAGE(PG8_SA(1, 0), cA + kstep, voffA); PG8_STAGE(PG8_SB(1, 1), cB + hstep + kstep, voffB);
        PG8_WAIT_V(6); PG8_BAR;
    } else {
        PG8_STAGE(PG8_SB(0, 0), cB, voffB); PG8_STAGE(PG8_SA(0, 0), cA, voffA); PG8_STAGE(PG8_SB(0, 1), cB + hstep, voffB); PG8_STAGE(PG8_SA(0, 1), cA + hstep, voffA);
        if (wr == 1) PG8_BAR;
        PG8_WAIT_V(4); PG8_BAR;
        PG8_STAGE(PG8_SB(1, 0), cB + kstep, voffB); PG8_STAGE(PG8_SA(1, 0), cA + kstep, voffA); PG8_STAGE(PG8_SB(1, 1), cB + hstep + kstep, voffB);
        PG8_WAIT_V(6); PG8_BAR;
    }
    for (;;) {
        const bool has_next = S.next(ui + 1, nxt);
        const char* nA = has_next ? (const char*)g.A + (size_t)nxt.pm * tstep : cA; const char* nB = has_next ? (const char*)g.Bt + (size_t)nxt.pn * tstep : cB;
        for (int t = 0; t < nt; t += 2) {
            const bool last = (t == nt - 2);
            const char* a1 = cA + (size_t)(t + 1) * kstep;
            const char* a2 = last ? nA : cA + (size_t)(t + 2) * kstep; const char* b2 = last ? nB : cB + (size_t)(t + 2) * kstep;
            const char* a3 = a2 + kstep; const char* b3 = b2 + kstep;
            if (last && has_next) S.a_ready(nxt);
            if constexpr (SP2) {
            PG8_LDB(B0, 0, 0); PG8_LDB(B1, 0, 1); PG8_SCHED; PG8_LDA(At, 0, 0); PG8_STAGE(PG8_SA(1, 1), a1 + hstep, voffA);
            PG8_WAIT_V(8); PG8_WAIT_L(0); PG8_BAR; PG8_MMA(0, 0, At, B0); PG8_MMA(0, 1, At, B1); PG8_BAR; PG8_SCHED;
            PG8_LDA(At, 0, 1); PG8_STAGE(PG8_SB(0, 0), b2, voffB); PG8_STAGE(PG8_SB(0, 1), b2 + hstep, voffB); PG8_STAGE(PG8_SA(0, 0), a2, voffA);
            PG8_WAIT_V(8); PG8_WAIT_L(0); PG8_BAR; PG8_MMA(1, 0, At, B0); PG8_MMA(1, 1, At, B1); PG8_BAR; PG8_SCHED;
            PG8_LDB(B0, 1, 0); PG8_LDB(B1, 1, 1); PG8_SCHED; PG8_LDA(At, 1, 0); PG8_STAGE(PG8_SA(0, 1), a2 + hstep, voffA);
            PG8_WAIT_V(8); PG8_WAIT_L(0); PG8_BAR; PG8_MMA(0, 0, At, B0); PG8_MMA(0, 1, At, B1); PG8_BAR; PG8_SCHED;
            PG8_LDA(At, 1, 1); PG8_STAGE(PG8_SB(1, 0), b3, voffB); PG8_STAGE(PG8_SB(1, 1), b3 + hstep, voffB); PG8_STAGE(PG8_SA(1, 0), a3, voffA);
            PG8_WAIT_V(8); PG8_WAIT_L(0); PG8_BAR; PG8_MMA(1, 0, At, B0); PG8_MMA(1, 1, At, B1); PG8_BAR; PG8_SCHED;
            } else {
            PG8_LDB(B0, 0, 0); PG8_SCHED; PG8_LDA(At, 0, 0); PG8_STAGE(PG8_SA(1, 1), a1 + hstep, voffA);
            PG8_WAIT_L(8); PG8_BAR; PG8_WAIT_L(0); PG8_MMA(0, 0, At, B0); PG8_BAR; PG8_SCHED;
            PG8_LDB(B1, 0, 1); PG8_STAGE(PG8_SB(0, 0), b2, voffB);
            PG8_BAR; PG8_WAIT_L(0); PG8_MMA(0, 1, At, B1); PG8_BAR;
            PG8_LDA(At, 0, 1); PG8_STAGE(PG8_SA(0, 0), a2, voffA);
            PG8_BAR; PG8_WAIT_L(0); PG8_MMA(1, 0, At, B0); PG8_BAR; PG8_SCHED;
            PG8_STAGE(PG8_SB(0, 1), b2 + hstep, voffB);
            PG8_WAIT_V(6); PG8_BAR; PG8_MMA(1, 1, At, B1); PG8_BAR;
            PG8_LDB(B0, 1, 0); PG8_SCHED; PG8_LDA(At, 1, 0); PG8_STAGE(PG8_SA(0, 1), a2 + hstep, voffA);
            PG8_WAIT_L(8); PG8_BAR; PG8_WAIT_L(0); PG8_MMA(0, 0, At, B0); PG8_BAR; PG8_SCHED;
            PG8_LDB(B1, 1, 1); PG8_STAGE(PG8_SB(1, 0), b3, voffB);
            PG8_BAR; PG8_WAIT_L(0); PG8_MMA(0, 1, At, B1); PG8_BAR;
            PG8_LDA(At, 1, 1); PG8_STAGE(PG8_SA(1, 0), a3, voffA);
            PG8_BAR; PG8_WAIT_L(0); PG8_MMA(1, 0, At, B0); PG8_BAR; PG8_SCHED;
            PG8_STAGE(PG8_SB(1, 1), b3 + hstep, voffB);
            PG8_WAIT_V(6); PG8_BAR; PG8_MMA(1, 1, At, B1); PG8_BAR;
            }
        }
        if constexpr (ALIGN_EPI) { if (wr == 0) PG8_BAR; }
        if constexpr (!Epi::AFTER_DRAIN) { E(acc, cur, wr, wc, fr, fq); S.done(cur); }
        if (!has_next) break;
        bool keep_acc = false; if constexpr (epi_keep<Epi>::value) keep_acc = E.keep_acc(cur);
        if (!keep_acc)
#pragma unroll
        for (int a = 0; a < 2; ++a)
#pragma unroll
            for (int b = 0; b < 2; ++b)
#pragma unroll
                for (int m = 0; m < 4; ++m)
#pragma unroll
                    for (int n = 0; n < 2; ++n) acc[a][b][m][n] = (f32x4){0.f, 0.f, 0.f, 0.f};
        cur = nxt; cA = nA; cB = nB; ++ui;
        if constexpr (ALIGN_EPI) { if (wr == 1) PG8_BAR; }
    }
    PG8_WAIT_V(0);
    if constexpr (!ALIGN_EPI) { if (wr == 0) PG8_BAR; }
    PG8_BAR;
    if constexpr (Epi::AFTER_DRAIN) { E.fused(acc, cur, wr, wc, fr, fq, lds, wid, lane); S.done(cur); }
#undef PG8_SA
#undef PG8_SB
#undef PG8_STAGE
#undef PG8_LDA
#undef PG8_LDB
#undef PG8_MMA
#undef PG8_WAIT_V
#undef PG8_WAIT_L
#undef PG8_BAR
#undef PG8_SCHED
}
}
#ifndef MP_REPS
#define MP_REPS 1
#endif
#ifndef MP1_REPS
#define MP1_REPS 1
#endif
#ifndef SM_REPS
#define SM_REPS 1
#endif
#ifndef P8_REPS
#define P8_REPS 1
#endif
#define LAS __attribute__((address_space(3)))
using pg8::bf16_t; using pg8::bf16x8; using pg8::f32x4; using pg8::u32x4; using pg8::Unit;
typedef float f32x2_t __attribute__((ext_vector_type(2))); typedef __bf16 bf16x2_t __attribute__((ext_vector_type(2)));
__device__ __forceinline__ unsigned cvt_pk_bf16(float lo, float hi) { f32x2_t v = {lo, hi}; bf16x2_t b = __builtin_convertvector(v, bf16x2_t); return __builtin_bit_cast(unsigned, b); }
typedef float f32x16 __attribute__((ext_vector_type(16)));
typedef unsigned u32x2 __attribute__((ext_vector_type(2)));

constexpr int NWAVES = 8, NTHR = 512;
constexpr int BATCH = 2, SEQ = 8192, T = BATCH * SEQ, D = 1024;
constexpr int DIN = 4264, DINP = 4352, NPROJ = 3840;
constexpr int QR = 384, KVR = 256, DFF = 2816, NUP = 5632;
constexpr float EPS = 1e-6f;
constexpr float LOG2E = 1.4426950408889634f;
constexpr float MLA_C = 0.10206207261596577f * LOG2E;
constexpr float FOX_C = 0.125f * LOG2E;
constexpr size_t MiB = 1u << 20;
constexpr size_t WS_WIN = 0, WS_WUQ = 9 * MiB, WS_WUKV = 10 * MiB, WS_WOM = 11 * MiB, WS_WOF = 12 * MiB, WS_WOUT = 13 * MiB, WS_WUP = 15 * MiB, WS_WDN = 26 * MiB;
constexpr size_t WS_HA = 32 * MiB;
constexpr size_t WS_CQ = 64 * MiB, WS_CKV = 76 * MiB, WS_KR = 84 * MiB;
constexpr size_t WS_SMALL = 85 * MiB;
constexpr size_t WS_ADA = WS_SMALL, WS_SSQ = WS_SMALL + 65536, WS_SSK = WS_SMALL + 2 * 65536, WS_BAR = WS_SMALL + 3 * 65536, WS_SS1 = WS_BAR + 16384, WS_SS2 = WS_SS1 + 65536, WS_CNT = WS_SS2 + 65536, ZERO_OFF = WS_SSQ, WS_NRM = WS_CNT + 32768, ZERO_BYTES = 2 * 65536 + 16384 + 2 * 65536 + 32768 + 256;
constexpr size_t WS_CS = 86 * MiB;
constexpr size_t WS_LF = 88 * MiB;
constexpr size_t WS_FB = 89 * MiB;
constexpr size_t WS_NF = 91 * MiB;
constexpr size_t WS_FQ = 96 * MiB, WS_FK = 112 * MiB, WS_FVT = 128 * MiB, WS_GM = 144 * MiB, WS_GF = 176 * MiB;
constexpr size_t WS_KN = 208 * MiB, WS_VMT = 224 * MiB, WS_OM = 240 * MiB, WS_OF = 64 * MiB;
constexpr size_t WS_Q = WS_HA, WS_T1 = WS_HA, WS_H2 = WS_HA, WS_Y = 96 * MiB, WS_ACT = 96 * MiB, WS_HALO = 184 * MiB, WS_PART = 195 * MiB;
constexpr int LDS_BYTES = 135168;

__device__ const double INVF[16] = {1.0, 0.5623413251903491, 0.31622776601683794, 0.1778279410038923, 0.1, 0.05623413251903491, 0.03162277660168379, 0.01778279410038923, 0.01, 0.005623413251903491, 0.0031622776601683794, 0.0017782794100389228, 0.001, 0.0005623413251903491, 0.00031622776601683794, 0.00017782794100389227};

__device__ __forceinline__ float bf2f(unsigned short b) { return __builtin_bit_cast(float, (unsigned)b << 16); }
__device__ __forceinline__ float bflo(unsigned w) { return __builtin_bit_cast(float, w << 16); }
__device__ __forceinline__ float bfhi(unsigned w) { return __builtin_bit_cast(float, w & 0xffff0000u); }
__device__ __forceinline__ unsigned short f2bf(float f) { return (unsigned short)(cvt_pk_bf16(f, 0.f) & 0xffffu); }
__device__ __forceinline__ u32x2 pack4(f32x4 v) { u32x2 w; w.x = cvt_pk_bf16(v[0], v[1]); w.y = cvt_pk_bf16(v[2], v[3]); return w; }
__device__ __forceinline__ void st_pair16(bf16_t* p0, u32x2 w0, u32x2 w1, int fq) {
    const auto sx = __builtin_amdgcn_permlane16_swap(w0.x, w1.x, false, false), sy = __builtin_amdgcn_permlane16_swap(w0.y, w1.y, false, false);
    *(u32x4*)(p0 + ((fq & 1) ? 12 : 0)) = (u32x4){sx[0], sy[0], sx[1], sy[1]};
}
__device__ __forceinline__ void ld_pair16(const bf16_t* p0, int fq, u32x2& w0, u32x2& w1) {
    const u32x4 t = *(const u32x4*)(p0 + ((fq & 1) ? 12 : 0));
    const auto sx = __builtin_amdgcn_permlane16_swap(t.x, t.z, false, false), sy = __builtin_amdgcn_permlane16_swap(t.y, t.w, false, false);
    w0 = (u32x2){sx[0], sy[0]}; w1 = (u32x2){sx[1], sy[1]};
}
__device__ __forceinline__ void st_pair16_if(bf16_t* p0, u32x2 w0, u32x2 w1, int fq, bool doit) {
    const auto sx = __builtin_amdgcn_permlane16_swap(w0.x, w1.x, false, false), sy = __builtin_amdgcn_permlane16_swap(w0.y, w1.y, false, false);
    if (doit) *(u32x4*)(p0 + ((fq & 1) ? 12 : 0)) = (u32x4){sx[0], sy[0], sx[1], sy[1]};
}
__device__ __forceinline__ float wave_sum(float v) {
#pragma unroll
    for (int o = 1; o < 64; o <<= 1) v += __shfl_xor(v, o);
    return v;
}
__device__ __forceinline__ float sigmoidf_(float x) { return __builtin_amdgcn_rcpf(1.0f + __expf(-x)); }
__device__ __forceinline__ float siluf_(float x) { return x * sigmoidf_(x); }

typedef const f32x4 (&AccRef)[2][2][4][2];

template <int BJ0, int BJ1, bool SSQ, bool RSC>
__device__ __forceinline__ void epi_store(AccRef acc, int row0, bf16_t* dst, int ld, int col0, float scale, float* ssq, const float* rss, float invk, int fq) {
#pragma unroll
    for (int ai = 0; ai < 2; ++ai)
#pragma unroll
        for (int m = 0; m < 4; ++m) {
            const int r = row0 + 128 * ai + 16 * m; float s = 0.f, sc = scale;
            if (RSC) sc *= __builtin_amdgcn_rsqf(rss[r] * invk + EPS);
#pragma unroll
            for (int bj = BJ0; bj < BJ1; ++bj) { const f32x4 v0 = acc[ai][bj][m][0], v1 = acc[ai][bj][m][1];
                if (SSQ) s += ((v0[0] * v0[0] + v0[1] * v0[1]) + (v0[2] * v0[2] + v0[3] * v0[3])) + ((v1[0] * v1[0] + v1[1] * v1[1]) + (v1[2] * v1[2] + v1[3] * v1[3]));
                st_pair16(dst + (size_t)r * ld + col0 + (bj - BJ0) * 128, pack4(v0 * sc), pack4(v1 * sc), fq); }
            if (SSQ) { s += __shfl_xor(s, 16); s += __shfl_xor(s, 32); if (fq == 0) atomicAdd(ssq + r, s); }
        }
}

struct EpiProj {
    static constexpr bool PERM = false, AFTER_DRAIN = false;
    bf16_t *CQ, *CKV, *KR, *FQ, *FK, *GM, *GF; float *LF, *SSQ, *SSK; const float *CS, *bforget;
    __device__ __forceinline__ void operator()(AccRef acc, const Unit& u, int wr, int wc, int fr_, int fq_) const {
        int ln_ = threadIdx.x & 63; asm volatile("" : "+v"(ln_)); const int fr = ln_ & 15, fq = ln_ >> 4; (void)fr_; (void)fq_;
        const int pn = u.pn, row0 = u.pm * 256 + wr * 64 + fr, cw = wc * 32 + 4 * fq;
        if (pn == 0) { epi_store<0, 2, true, false>(acc, row0, CQ, QR, cw, 1.f, SSQ, nullptr, 0.f, fq); }
        else if (pn == 1) {
            epi_store<0, 1, true, false>(acc, row0, CQ, QR, 256 + cw, 1.f, SSQ, nullptr, 0.f, fq);
            if (wc == 0) {
#pragma unroll
                for (int ai = 0; ai < 2; ++ai)
#pragma unroll
                    for (int m = 0; m < 4; ++m) { const int r = row0 + 128 * ai + 16 * m;
                        const f32x4 c = *(const f32x4*)(CS + (size_t)r * 16 + 4 * fq), s = *(const f32x4*)(CS + (size_t)T * 16 + (size_t)r * 16 + 4 * fq);
                        const f32x4 x1 = acc[ai][1][m][0], x2 = acc[ai][1][m][1];
                        st_pair16(KR + (size_t)r * 32 + 4 * fq, pack4(x1 * c - x2 * s), pack4(x2 * c + x1 * s), fq); }
            } else if (wc == 1) {
                if (fq < 2) {
                    const f32x4 bfg = *(const f32x4*)(bforget + 4 * fq);
#pragma unroll
                    for (int ai = 0; ai < 2; ++ai)
#pragma unroll
                        for (int m = 0; m < 4; ++m) { const int r = row0 + 128 * ai + 16 * m; const f32x4 z = acc[ai][1][m][0] + bfg; f32x4 o;
#pragma unroll
                            for (int j = 0; j < 4; ++j) o[j] = fminf(z[j], 0.f) - log1pf(expf(-fabsf(z[j])));
                            *(f32x4*)(LF + (size_t)r * 8 + 4 * fq) = o; }
                }
            }
        }
        else if (pn == 2) { epi_store<0, 2, true, false>(acc, row0, CKV, KVR, cw, 1.f, SSK, nullptr, 0.f, fq); }
        else if (pn <= 4) { epi_store<0, 2, false, false>(acc, row0, FQ, 512, (pn - 3) * 256 + cw, FOX_C, nullptr, nullptr, 0.f, fq); }
        else if (pn <= 6) { epi_store<0, 2, false, false>(acc, row0, FK, 512, (pn - 5) * 256 + cw, 1.f, nullptr, nullptr, 0.f, fq); }
        else {
            bf16_t* G = pn <= 10 ? GM : GF; const int cb = ((pn - 7) & 3) * 256 + cw;
#pragma unroll
            for (int ai = 0; ai < 2; ++ai)
#pragma unroll
                for (int m = 0; m < 4; ++m) { const int r = row0 + 128 * ai + 16 * m;
#pragma unroll
                    for (int bj = 0; bj < 2; ++bj) { f32x4 o[2];
#pragma unroll
                        for (int n = 0; n < 2; ++n) { const f32x4 v = acc[ai][bj][m][n];
#pragma unroll
                            for (int j = 0; j < 4; ++j) o[n][j] = fmaxf(sigmoidf_(v[j]), 8.6736174e-19f); }
                        st_pair16(G + (size_t)r * D + cb + bj * 128, pack4(o[0]), pack4(o[1]), fq); } }
        }
    }
};

struct EpiVt {
    static constexpr bool PERM = false, AFTER_DRAIN = false;
    bf16_t* dst; const float* ss; float invk;
    __device__ __forceinline__ void operator()(AccRef acc, const Unit& u, int wr, int wc, int fr_, int fq_) const {
        int ln_ = threadIdx.x & 63; asm volatile("" : "+v"(ln_)); const int fr = ln_ & 15, fq = ln_ >> 4; (void)fr_; (void)fq_;
        const int row0 = u.pm * 256 + wr * 64 + fr, c0 = u.pn * 256 + wc * 32 + 4 * fq;
        f32x4 sc[2][2];
#pragma unroll
        for (int bj = 0; bj < 2; ++bj)
#pragma unroll
            for (int n = 0; n < 2; ++n) { sc[bj][n] = (f32x4){1.f, 1.f, 1.f, 1.f};
                if (ss) { const f32x4 q = *(const f32x4*)(ss + c0 + bj * 128 + 16 * n);
#pragma unroll
                    for (int j = 0; j < 4; ++j) sc[bj][n][j] = __builtin_amdgcn_rsqf(q[j] * invk + EPS); } }
#pragma unroll
        for (int ai = 0; ai < 2; ++ai)
#pragma unroll
            for (int m = 0; m < 4; ++m) { const int r = row0 + 128 * ai + 16 * m;
#pragma unroll
                for (int bj = 0; bj < 2; ++bj)
                    st_pair16(dst + (size_t)r * T + c0 + bj * 128, pack4(acc[ai][bj][m][0] * sc[bj][0]), pack4(acc[ai][bj][m][1] * sc[bj][1]), fq); }
    }
};

struct EpiQ {
    static constexpr bool PERM = false, AFTER_DRAIN = false;
    bf16_t* Q; const float *SSQ, *CS;
    __device__ __forceinline__ void operator()(AccRef acc, const Unit& u, int wr, int wc, int fr_, int fq_) const {
        int ln_ = threadIdx.x & 63; asm volatile("" : "+v"(ln_)); const int fr = ln_ & 15, fq = ln_ >> 4; (void)fr_; (void)fq_;
        const int row0 = u.pm * 256 + wr * 64 + fr;
        const bool rope0 = ((8 * u.pn + wc) % 3) == 2, rope1 = ((8 * u.pn + 4 + wc) % 3) == 2;
        float ssv[8];
#pragma unroll
        for (int t = 0; t < 8; ++t) ssv[t] = SSQ[row0 + 128 * (t >> 2) + 16 * (t & 3)];
#pragma unroll
        for (int ai = 0; ai < 2; ++ai)
#pragma unroll
            for (int m = 0; m < 4; ++m) { const int r = row0 + 128 * ai + 16 * m;
                const float rs = __builtin_amdgcn_rsqf(ssv[4 * ai + m] * (1.0f / QR) + EPS) * MLA_C;
                f32x4 c = (f32x4){0.f, 0.f, 0.f, 0.f}, s = c;
                if (rope0 || rope1) { c = *(const f32x4*)(CS + (size_t)r * 16 + 4 * fq); s = *(const f32x4*)(CS + (size_t)T * 16 + (size_t)r * 16 + 4 * fq); }
#pragma unroll
                for (int bj = 0; bj < 2; ++bj) { const bool isrope = bj ? rope1 : rope0;
                    f32x4 v0 = acc[ai][bj][m][0] * rs, v1 = acc[ai][bj][m][1] * rs;
                    if (isrope) { const f32x4 o0 = v0 * c - v1 * s, o1 = v1 * c + v0 * s; v0 = o0; v1 = o1; }
                    st_pair16(Q + (size_t)r * 768 + u.pn * 256 + bj * 128 + wc * 32 + 4 * fq, pack4(v0), pack4(v1), fq); }
                asm volatile("" ::: "memory"); }
    }
};

struct EpiKN {
    static constexpr bool PERM = false, AFTER_DRAIN = false;
    bf16_t* KN; const float* SSK;
    __device__ __forceinline__ void operator()(AccRef acc, const Unit& u, int wr, int wc, int fr_, int fq_) const {
        int ln_ = threadIdx.x & 63; asm volatile("" : "+v"(ln_)); const int fr = ln_ & 15, fq = ln_ >> 4; (void)fr_; (void)fq_;
        epi_store<0, 2, false, true>(acc, u.pm * 256 + wr * 64 + fr, KN, 512, u.pn * 256 + wc * 32 + 4 * fq, 1.f, nullptr, SSK, 1.0f / KVR, fq);
    }
};

template <bool SECOND> struct EpiGate {
    static constexpr bool PERM = false, AFTER_DRAIN = false;
    const bf16_t* G; const bf16_t* T1; bf16_t* O;
    __device__ __forceinline__ void operator()(AccRef acc, const Unit& u, int wr, int wc, int fr_, int fq_) const {
        int ln_ = threadIdx.x & 63; asm volatile("" : "+v"(ln_)); const int fr = ln_ & 15, fq = ln_ >> 4; (void)fr_; (void)fq_;
        const int row0 = u.pm * 256 + wr * 64 + fr, c0 = u.pn * 256 + wc * 32 + 4 * fq;
#pragma unroll
        for (int ai = 0; ai < 2; ++ai)
#pragma unroll
            for (int m = 0; m < 4; ++m) { const size_t ro = (size_t)(row0 + 128 * ai + 16 * m) * D + c0;
#pragma unroll
                for (int bj = 0; bj < 2; ++bj)
#pragma unroll
                    for (int n = 0; n < 2; ++n) { const size_t o = ro + bj * 128 + 16 * n; const u32x2 g = *(const u32x2*)(G + o);
                        f32x4 v = acc[ai][bj][m][n] * (f32x4){bflo(g.x), bfhi(g.x), bflo(g.y), bfhi(g.y)};
                        if (SECOND) { const u32x2 t = *(const u32x2*)(T1 + o); v += (f32x4){bflo(t.x), bfhi(t.x), bflo(t.y), bfhi(t.y)}; }
                        *(u32x2*)(O + o) = pack4(v); } }
    }
};

constexpr int PAIR_DPM = (int)(((long long)WS_OF - (long long)WS_OM) / (256 * 512 * 2)), PAIR_DPN = (int)((WS_WOF - WS_WOM) / (256 * 512 * 2));
static_assert((long long)PAIR_DPM * (256 * 512 * 2) == (long long)WS_OF - (long long)WS_OM && (size_t)PAIR_DPN * (256 * 512 * 2) == WS_WOF - WS_WOM, "pair offsets are whole tiles");
struct PairOrder {
    pg8::StaticOrder S0;
    __device__ bool next(int i, Unit& u) const { if (!S0.next(i >> 1, u)) return false; if (i & 1) { u.pm += PAIR_DPM; u.pn += PAIR_DPN; } return true; }
    __device__ __forceinline__ void a_ready(const Unit&) const {}
    __device__ __forceinline__ void done(const Unit&) const {}
};
struct EpiGate2 {
    static constexpr bool PERM = false, AFTER_DRAIN = false, KEEP = true;
    const bf16_t *GMp, *GFp; bf16_t* Yp;
    __device__ __forceinline__ bool keep_acc(const Unit& u) const { return u.pn < 4; }
    __device__ __forceinline__ void operator()(f32x4 (&acc)[2][2][4][2], const Unit& u, int wr, int wc, int fr_, int fq_) const {
        int ln_ = threadIdx.x & 63; asm volatile("" : "+v"(ln_)); const int fr = ln_ & 15, fq = ln_ >> 4; (void)fr_; (void)fq_;
        const bool first = u.pn < 4; const int pm = first ? u.pm : u.pm - PAIR_DPM, pn = first ? u.pn : u.pn - PAIR_DPN;
        const int row0 = pm * 256 + wr * 64 + fr, c0 = pn * 256 + wc * 32 + 4 * fq;
#pragma unroll
        for (int ai = 0; ai < 2; ++ai)
#pragma unroll
            for (int m = 0; m < 4; ++m) { const size_t ro = (size_t)(row0 + 128 * ai + 16 * m) * D + c0;
#pragma unroll
                for (int bj = 0; bj < 2; ++bj) { u32x2 yw[2], gfw[2], gmw[2]; ld_pair16(GFp + ro + bj * 128, fq, gfw[0], gfw[1]);
                    if (first) ld_pair16(GMp + ro + bj * 128, fq, gmw[0], gmw[1]); else { gmw[0] = (u32x2){0u, 0u}; gmw[1] = gmw[0]; }
#pragma unroll
                    for (int n = 0; n < 2; ++n) { const u32x2 gf = gfw[n];
                        const f32x4 s2 = (f32x4){bflo(gf.x), bfhi(gf.x), bflo(gf.y), bfhi(gf.y)};
                        if (first) { const u32x2 gm = gmw[n]; f32x4 rt;
#pragma unroll
                            for (int j = 0; j < 4; ++j) rt[j] = __builtin_amdgcn_rcpf(s2[j]);
                            acc[ai][bj][m][n] = acc[ai][bj][m][n] * ((f32x4){bflo(gm.x), bfhi(gm.x), bflo(gm.y), bfhi(gm.y)} * rt); yw[n] = (u32x2){0u, 0u}; }
                        else yw[n] = pack4(acc[ai][bj][m][n] * s2); }
                    if (!first) st_pair16(Yp + ro + bj * 128, yw[0], yw[1], fq); }
                asm volatile("" ::: "memory"); }
    }
};

struct EpiRes {
    static constexpr bool PERM = false, AFTER_DRAIN = false;
    const float* base; float* out; const float* gate;
    __device__ __forceinline__ void operator()(AccRef acc, const Unit& u, int wr, int wc, int fr_, int fq_) const {
        int ln_ = threadIdx.x & 63; asm volatile("" : "+v"(ln_)); const int fr = ln_ & 15, fq = ln_ >> 4; (void)fr_; (void)fq_;
        const int row0 = u.pm * 256 + wr * 64 + fr, c0 = u.pn * 256 + wc * 32 + 4 * fq; const float* gp = gate + (u.pm >> 5) * 6144 + c0;
        f32x4 gv[2][2];
#pragma unroll
        for (int bj = 0; bj < 2; ++bj)
#pragma unroll
            for (int n = 0; n < 2; ++n) gv[bj][n] = *(const f32x4*)(gp + bj * 128 + 16 * n);
#pragma unroll
        for (int ai = 0; ai < 2; ++ai)
#pragma unroll
            for (int m = 0; m < 4; ++m) { const size_t ro = (size_t)(row0 + 128 * ai + 16 * m) * D + c0;
#pragma unroll
                for (int bj = 0; bj < 2; ++bj)
#pragma unroll
                    for (int n = 0; n < 2; ++n) { const size_t o = ro + bj * 128 + 16 * n; const f32x4 b = *(const f32x4*)(base + o);
                        *(f32x4*)(out + o) = b + gv[bj][n] * acc[ai][bj][m][n]; }
                asm volatile("" ::: "memory"); }
    }
};

template <bool FINAL> struct EpiResNorm {
    static constexpr bool PERM = false, AFTER_DRAIN = true;
    const float* base; float* out; const float* gate; float* ss; unsigned* cnt; const float* g; const float* sc; const float* sh; bf16_t* H;
    __device__ __forceinline__ void fused(f32x4 (&acc)[2][2][4][2], const Unit& u, int wr, int wc, int fr_, int fq_, LAS unsigned char* lds, int wid, int lane_) const {
        int ln_ = threadIdx.x & 63; asm volatile("" : "+v"(ln_)); const int fr = ln_ & 15, fq = ln_ >> 4; (void)fr_; (void)fq_; (void)lds; (void)wid; (void)lane_;
        const int row0 = u.pm * 256 + wr * 64 + fr, c0 = u.pn * 256 + wc * 32 + 4 * fq, b = u.pm >> 5; const float* gp = gate + b * 6144 + c0;
        {   f32x4 gv[2][2];
#pragma unroll
            for (int bj = 0; bj < 2; ++bj)
#pragma unroll
                for (int n = 0; n < 2; ++n) gv[bj][n] = *(const f32x4*)(gp + bj * 128 + 16 * n);
#pragma unroll
            for (int ai = 0; ai < 2; ++ai)
#pragma unroll
                for (int m = 0; m < 4; ++m) { const int r = row0 + 128 * ai + 16 * m; const size_t ro = (size_t)r * D + c0; float s = 0.f;
#pragma unroll
                    for (int bj = 0; bj < 2; ++bj)
#pragma unroll
                        for (int n = 0; n < 2; ++n) { const size_t o = ro + bj * 128 + 16 * n; const f32x4 xn = *(const f32x4*)(base + o) + gv[bj][n] * acc[ai][bj][m][n];
                            acc[ai][bj][m][n] = xn; s += (xn[0] * xn[0] + xn[1] * xn[1]) + (xn[2] * xn[2] + xn[3] * xn[3]); }
                    s += __shfl_xor(s, 16); s += __shfl_xor(s, 32); if (fq == 0) atomicAdd(ss + r, s);
                    asm volatile("" ::: "memory"); } }
        asm volatile("s_waitcnt vmcnt(0)" ::: "memory");
        __syncthreads();
        if (threadIdx.x == 0) {
            unsigned* cw = cnt + 64 * u.pm;
            __hip_atomic_fetch_add(cw, 1u, __ATOMIC_RELAXED, __HIP_MEMORY_SCOPE_AGENT);
        }
        if (!FINAL) {
#pragma unroll
            for (int ai = 0; ai < 2; ++ai)
#pragma unroll
                for (int m = 0; m < 4; ++m) { const size_t ro = (size_t)(row0 + 128 * ai + 16 * m) * D + c0;
#pragma unroll
                    for (int bj = 0; bj < 2; ++bj)
#pragma unroll
                        for (int n = 0; n < 2; ++n) *(f32x4*)(out + ro + bj * 128 + 16 * n) = acc[ai][bj][m][n]; }
        }
        if (threadIdx.x == 0) {
            unsigned* cw = cnt + 64 * u.pm;
            unsigned sp = 0;
            while (__hip_atomic_load(cw, __ATOMIC_RELAXED, __HIP_MEMORY_SCOPE_AGENT) < 4u) { __builtin_amdgcn_s_sleep(1); if (++sp > (1u << 22)) break; }
        }
        __syncthreads();
        f32x4 cA[2][2], cB[2][2];
#pragma unroll
        for (int bj = 0; bj < 2; ++bj)
#pragma unroll
            for (int n = 0; n < 2; ++n) { const int c = c0 + bj * 128 + 16 * n; cA[bj][n] = *(const f32x4*)(g + c);
                if (!FINAL) { cA[bj][n] = cA[bj][n] * (*(const f32x4*)(sc + b * 6144 + c) + 1.0f); cB[bj][n] = *(const f32x4*)(sh + b * 6144 + c); } else cB[bj][n] = (f32x4){0.f, 0.f, 0.f, 0.f}; }
#pragma unroll
        for (int ai = 0; ai < 2; ++ai)
#pragma unroll
            for (int m = 0; m < 4; ++m) { const int r = row0 + 128 * ai + 16 * m; const size_t ro = (size_t)r * D + c0;
                const float rstd = __builtin_amdgcn_rsqf(__hip_atomic_load(ss + r, __ATOMIC_RELAXED, __HIP_MEMORY_SCOPE_AGENT) * (1.0f / D) + EPS);
#pragma unroll
                for (int bj = 0; bj < 2; ++bj) { u32x2 hw[2];
#pragma unroll
                    for (int n = 0; n < 2; ++n) { const size_t o = ro + bj * 128 + 16 * n; const f32x4 y = acc[ai][bj][m][n] * rstd * cA[bj][n];
                        if (FINAL) { *(f32x4*)(out + o) = y; hw[n] = (u32x2){0u, 0u}; }
                        else hw[n] = pack4(y + cB[bj][n]); }
                    if (!FINAL) st_pair16(H + ro + bj * 128, hw[0], hw[1], fq); }
                asm volatile("" ::: "memory"); }
    }
};

__device__ __forceinline__ f32x4 shfl4(f32x4 v, int src) { f32x4 o;
#pragma unroll
    for (int j = 0; j < 4; ++j) o[j] = __shfl(v[j], src);
    return o; }
struct EpiConv {
    static constexpr bool PERM = false, AFTER_DRAIN = false;
    bf16_t* ACT; float *HALO, *PART; const float *cw, *cb;
    __device__ __forceinline__ void operator()(AccRef acc, const Unit& u, int wr, int wc, int fr_, int fq_) const {
        int ln_ = threadIdx.x & 63; asm volatile("" : "+v"(ln_)); const int fr = ln_ & 15, fq = ln_ >> 4; (void)fr_; (void)fq_;
        const int lane = fq * 16 + fr, s1 = fq * 16 + ((fr + 15) & 15), s2 = fq * 16 + ((fr + 14) & 15);
#pragma unroll
        for (int ai = 0; ai < 2; ++ai) { const int grp = 4 * u.pm + 2 * ai + wr, r0 = 64 * grp + fr; u32x2 aw0[4];
#pragma unroll
            for (int n = 0; n < 2; ++n) { const int ng = 128 * u.pn + 32 * wc + 16 * n + 4 * fq;
                const f32x4 wg0 = *(const f32x4*)(cw + ng), wg1 = *(const f32x4*)(cw + NUP + ng), wg2 = *(const f32x4*)(cw + 2 * NUP + ng), bg = *(const f32x4*)(cb + ng);
                const f32x4 wv0 = *(const f32x4*)(cw + DFF + ng), wv1 = *(const f32x4*)(cw + NUP + DFF + ng), wv2 = *(const f32x4*)(cw + 2 * NUP + DFF + ng), bv = *(const f32x4*)(cb + DFF + ng);
                f32x4 pg1 = (f32x4){0.f, 0.f, 0.f, 0.f}, pg2 = pg1, pv1 = pg1, pv2 = pg1;
#pragma unroll
                for (int m = 0; m < 4; ++m) { const f32x4 G = acc[ai][0][m][n], V = acc[ai][1][m][n];
                    const f32x4 g1 = shfl4(G, s1), g2 = shfl4(G, s2), v1 = shfl4(V, s1), v2 = shfl4(V, s2);
                    const f32x4 gm1 = fr >= 1 ? g1 : pg1, gm2 = fr >= 2 ? g2 : pg2, vm1 = fr >= 1 ? v1 : pv1, vm2 = fr >= 2 ? v2 : pv2;
                    const f32x4 cg = bg + wg0 * gm2 + wg1 * gm1 + wg2 * G, cv = bv + wv0 * vm2 + wv1 * vm1 + wv2 * V;
                    const int r = r0 + 16 * m;
                    if (m == 0 && fr < 2) { *(f32x4*)(PART + ((size_t)grp * 2 + fr) * NUP + ng) = cg; *(f32x4*)(PART + ((size_t)grp * 2 + fr) * NUP + DFF + ng) = cv; }
                    { f32x4 a;
#pragma unroll
                        for (int j = 0; j < 4; ++j) a[j] = siluf_(cg[j]) * cv[j];
                        if (n == 0) { aw0[m] = pack4(a); asm volatile("" : "+v"(aw0[m].x), "+v"(aw0[m].y)); }
                        else st_pair16_if(ACT + (size_t)r * DFF + ng - 16, aw0[m], pack4(a), fq, !(m == 0 && fr < 2)); }
                    if (m == 3 && fr >= 14) { *(f32x4*)(HALO + ((size_t)grp * 2 + (fr - 14)) * NUP + ng) = G; *(f32x4*)(HALO + ((size_t)grp * 2 + (fr - 14)) * NUP + DFF + ng) = V; }
                    pg1 = g1; pg2 = g2; pv1 = v1; pv2 = v2;
                    asm volatile("" ::: "memory"); }
                (void)lane; } }
    }
};

__device__ __forceinline__ int crow(int r, int hi) { return (r & 3) + 8 * (r >> 2) + 4 * hi; }
constexpr int VSTR = 264, ATT_VOFF = 2 * 128 * 208;
template <int NCH> struct AttLoader { const bf16_t* ksrc[3]; size_t kstp[3]; int kdst[3]; bool kact[3]; const bf16_t* vsrc[2]; int vdst[2]; };
template <int NCH> __device__ __forceinline__ void att_load(const AttLoader<NCH>& L, int it, u32x4 (&kr)[3], u32x4 (&vr)[2]) {
#pragma unroll
    for (int i = 0; i < 3; ++i) if (L.kact[i]) kr[i] = *(const u32x4*)(L.ksrc[i] + (size_t)it * L.kstp[i]);
#pragma unroll
    for (int i = 0; i < 2; ++i) vr[i] = *(const u32x4*)(L.vsrc[i] + (size_t)it * 128);
}
template <int NCH, int KSTR> __device__ __forceinline__ void att_write(LAS unsigned char* lds, const AttLoader<NCH>& L, int buf, const u32x4 (&kr)[3], const u32x4 (&vr)[2]) {
#pragma unroll
    for (int i = 0; i < 3; ++i) if (L.kact[i]) *(LAS u32x4*)(lds + buf * (128 * KSTR) + L.kdst[i]) = kr[i];
#pragma unroll
    for (int i = 0; i < 2; ++i) { *(LAS u32x2*)(lds + L.vdst[i] + buf * (64 * VSTR)) = (u32x2){vr[i].x, vr[i].y}; *(LAS u32x2*)(lds + L.vdst[i] + buf * (64 * VSTR) + 8) = (u32x2){vr[i].z, vr[i].w}; }
}
struct AttState { f32x16 o0, o1, negm; float mref, lrun; };
template <int NSTEP, int KSTR> __device__ __forceinline__ void att_compute(LAS unsigned char* lds, int it, int buf, bool first, int wq0, int qrow, int r32, int hi, const bf16x8 (&qf)[NSTEP], AttState& S) {
    const LAS unsigned char* kbuf = lds + buf * (128 * KSTR);
#pragma unroll
    for (int s = 0; s < 2; ++s) { if ((128 * it + 64 * s) <= wq0 + 31) {
        f32x16 p[2];
        {
            bf16x8 kf[2][NSTEP];
#pragma unroll
            for (int hh = 0; hh < 2; ++hh)
#pragma unroll
                for (int d0 = 0; d0 < NSTEP; ++d0) kf[hh][d0] = *(const LAS bf16x8*)(kbuf + (64 * s + 32 * hh + r32) * KSTR + d0 * 32 + hi * 16);
            __builtin_amdgcn_sched_barrier(0);
            if (NSTEP == 5) { if (hi) { kf[0][4] = (bf16x8){0, 0, 0, 0, 0, 0, 0, 0}; kf[1][4] = (bf16x8){0, 0, 0, 0, 0, 0, 0, 0}; } }
            f32x16 a0 = S.negm, a1 = S.negm;
#pragma unroll
            for (int d0 = 0; d0 < NSTEP; ++d0) { a0 = __builtin_amdgcn_mfma_f32_32x32x16_bf16(kf[0][d0], qf[d0], a0, 0, 0, 0); a1 = __builtin_amdgcn_mfma_f32_32x32x16_bf16(kf[1][d0], qf[d0], a1, 0, 0, 0); }
            p[0] = a0; p[1] = a1; }
        const int kv0 = 128 * it + 64 * s;
        if (kv0 + 63 > wq0) {
#pragma unroll
            for (int hh = 0; hh < 2; ++hh)
#pragma unroll
                for (int r = 0; r < 16; ++r) { const int kvg = kv0 + 32 * hh + crow(r, hi); if (kvg > qrow) p[hh][r] = -INFINITY; }
        }
        float mx = fmaxf(fmaxf(p[0][0], p[1][0]), fmaxf(p[0][1], p[1][1]));
#pragma unroll
        for (int r = 2; r < 16; r += 2) mx = fmaxf(fmaxf(mx, p[0][r]), fmaxf(fmaxf(p[1][r], p[0][r + 1]), p[1][r + 1]));
        mx = fmaxf(mx, __shfl_xor(mx, 32));
        if ((first && s == 0) || __any(mx > 24.0f)) {
            const float delta = (first && s == 0) ? mx : fmaxf(mx, 0.f), sc = __builtin_amdgcn_exp2f(-delta);
            S.mref += delta; S.lrun *= sc;
#pragma unroll
            for (int r = 0; r < 16; ++r) { S.o0[r] *= sc; S.o1[r] *= sc; p[0][r] -= delta; p[1][r] -= delta; S.negm[r] = -S.mref; }
        }
        const LAS unsigned char* vb = lds + ATT_VOFF + buf * (64 * VSTR) + r32 * VSTR + s * 128 + hi * 8;
        u32x2 vf[2][4][2];
#pragma unroll
        for (int db = 0; db < 2; ++db)
#pragma unroll
            for (int j = 0; j < 4; ++j) { vf[db][j][0] = *(const LAS u32x2*)(vb + db * 32 * VSTR + j * 32); vf[db][j][1] = *(const LAS u32x2*)(vb + db * 32 * VSTR + j * 32 + 16); }
        __builtin_amdgcn_sched_barrier(0);
        float rs0 = 0.f, rs1 = 0.f;
#pragma unroll
        for (int r = 0; r < 16; ++r) { const float e0 = __builtin_amdgcn_exp2f(p[0][r]), e1 = __builtin_amdgcn_exp2f(p[1][r]); p[0][r] = e0; p[1][r] = e1; rs0 += e0; rs1 += e1; }
        S.lrun += rs0 + rs1;
        bf16x8 pb[4];
#pragma unroll
        for (int j = 0; j < 4; ++j) { const int hh = j >> 1, rb = 8 * (j & 1);
            const unsigned w0 = cvt_pk_bf16(p[hh][rb + 0], p[hh][rb + 1]), w1 = cvt_pk_bf16(p[hh][rb + 2], p[hh][rb + 3]), w2 = cvt_pk_bf16(p[hh][rb + 4], p[hh][rb + 5]), w3 = cvt_pk_bf16(p[hh][rb + 6], p[hh][rb + 7]);
            pb[j] = __builtin_bit_cast(bf16x8, (u32x4){w0, w1, w2, w3}); }
#pragma unroll
        for (int j = 0; j < 4; ++j) {
            S.o0 = __builtin_amdgcn_mfma_f32_32x32x16_bf16(__builtin_bit_cast(bf16x8, (u32x4){vf[0][j][0].x, vf[0][j][0].y, vf[0][j][1].x, vf[0][j][1].y}), pb[j], S.o0, 0, 0, 0);
            S.o1 = __builtin_amdgcn_mfma_f32_32x32x16_bf16(__builtin_bit_cast(bf16x8, (u32x4){vf[1][j][0].x, vf[1][j][0].y, vf[1][j][1].x, vf[1][j][1].y}), pb[j], S.o1, 0, 0, 0); }
    } }
}
template <int NSTEP, int NCH, int KSTR>
__device__ __forceinline__ void attn_unit(LAS unsigned char* lds, int b, int h, int qb, const bf16_t* Qp, int qld, int qcol,
                                          const bf16_t* K1, int k1ld, int k1col, const bf16_t* K2, int k2ld, int k2col, const bf16_t* Vt, int vrow0, bf16_t* O, int ocol, int it0) {
    int tid_ = threadIdx.x; asm volatile("" : "+v"(tid_));
    const int tid = tid_, lane = tid & 63, r32 = lane & 31, hi = lane >> 5, wid = __builtin_amdgcn_readfirstlane(tid >> 6);
    const size_t rowbase = (size_t)b * SEQ;
    const int qrow = 256 * qb + 32 * wid + r32;
    bf16x8 qf[NSTEP];
#pragma unroll
    for (int d0 = 0; d0 < (NSTEP == 6 ? 6 : 4); ++d0) qf[d0] = *(const bf16x8*)(Qp + (rowbase + qrow) * qld + qcol + 16 * d0 + 8 * hi);
    if (NSTEP == 5) { const short one = hi ? (short)0 : (short)0x3F80; qf[NSTEP - 1] = (bf16x8){one, one, one, 0, 0, 0, 0, 0}; }
    AttLoader<NCH> L;
#pragma unroll
    for (int i = 0; i < 3; ++i) { const int idx = tid + 512 * i; L.kact[i] = idx < 128 * NCH; const int row = idx / NCH, c = idx % NCH;
        L.ksrc[i] = c < 8 ? K1 + (rowbase + row) * k1ld + k1col + 8 * c : K2 + (rowbase + row) * k2ld + k2col + 8 * (c - 8);
        L.kstp[i] = (size_t)128 * (c < 8 ? k1ld : k2ld); L.kdst[i] = row * KSTR + c * 16; }
#pragma unroll
    for (int i = 0; i < 2; ++i) { const int idx = tid + 512 * i, d = idx >> 4, c = idx & 15; L.vsrc[i] = Vt + (size_t)(vrow0 + d) * T + rowbase + 8 * c; L.vdst[i] = ATT_VOFF + d * VSTR + c * 16; }
    const int NIT = 2 * qb + 2;
    u32x4 kA[3], vA[2], kB[3], vB[2];
    att_load<NCH>(L, it0, kA, vA); att_write<NCH, KSTR>(lds, L, 0, kA, vA);
    att_load<NCH>(L, it0 + 1, kB, vB);
    __syncthreads();
    AttState S; S.o0 = f32x16{}; S.o1 = f32x16{}; S.negm = f32x16{}; S.mref = 0.f; S.lrun = 0.f;
    const int wq0 = 256 * qb + 32 * wid;
    for (int it = it0; it < NIT; it += 2) {
        if (it + 2 < NIT) att_load<NCH>(L, it + 2, kA, vA);
        att_compute<NSTEP, KSTR>(lds, it, 0, it == it0, wq0, qrow, r32, hi, qf, S);
        att_write<NCH, KSTR>(lds, L, 1, kB, vB);
        __syncthreads();
        if (it + 3 < NIT) att_load<NCH>(L, it + 3, kB, vB);
        att_compute<NSTEP, KSTR>(lds, it + 1, 1, false, wq0, qrow, r32, hi, qf, S);
        if (it + 2 < NIT) att_write<NCH, KSTR>(lds, L, 0, kA, vA);
        __syncthreads();
    }
    float lrun = S.lrun; lrun += __shfl_xor(lrun, 32);
    const float inv = 1.0f / lrun;
    bf16_t* op = O + (rowbase + qrow) * 512 + ocol + 8 * hi;
#pragma unroll
    for (int k = 0; k < 2; ++k) {
        const u32x2 a0 = pack4((f32x4){S.o0[8 * k], S.o0[8 * k + 1], S.o0[8 * k + 2], S.o0[8 * k + 3]} * inv), a1 = pack4((f32x4){S.o0[8 * k + 4], S.o0[8 * k + 5], S.o0[8 * k + 6], S.o0[8 * k + 7]} * inv);
        const u32x2 b0 = pack4((f32x4){S.o1[8 * k], S.o1[8 * k + 1], S.o1[8 * k + 2], S.o1[8 * k + 3]} * inv), b1 = pack4((f32x4){S.o1[8 * k + 4], S.o1[8 * k + 5], S.o1[8 * k + 6], S.o1[8 * k + 7]} * inv);
        const auto ax = __builtin_amdgcn_permlane32_swap(a0.x, a1.x, false, false), ay = __builtin_amdgcn_permlane32_swap(a0.y, a1.y, false, false);
        const auto bx = __builtin_amdgcn_permlane32_swap(b0.x, b1.x, false, false), by = __builtin_amdgcn_permlane32_swap(b0.y, b1.y, false, false);
        *(u32x4*)(op + 16 * k) = (u32x4){ax[0], ay[0], ax[1], ay[1]};
        *(u32x4*)(op + 32 + 16 * k) = (u32x4){bx[0], by[0], bx[1], by[1]}; }
}

#define XB_TMO      128
#define XB_XCNT(j)  (256  + 64 * (j))
#define XB_XSUB(j)  (1280 + 64 * (j))
#define XB_XGEN(j)  (2304 + 64 * (j))
#define XB_TOP      3328
#define XB_TOPGEN   3392
#define XCD_BAR_WORDS 3456
#define XB_SPIN_CAP (1u << 18)

__device__ __forceinline__ unsigned xb_ld(unsigned* p)              { return __hip_atomic_load(p, __ATOMIC_RELAXED, __HIP_MEMORY_SCOPE_AGENT); }
__device__ __forceinline__ unsigned xb_add(unsigned* p, unsigned v) { return __hip_atomic_fetch_add(p, v, __ATOMIC_RELAXED, __HIP_MEMORY_SCOPE_AGENT); }
__device__ __forceinline__ unsigned xb_xcc_id() { return (unsigned)__builtin_amdgcn_s_getreg((3 << 11) | 20) & 0xFu; }
#define XB_SPIN(cond, bar) do { unsigned _sp = 0; while (cond) { __builtin_amdgcn_s_sleep(1); \
    if ((++_sp & 255u) == 0u) { if (xb_ld(&(bar)[XB_TMO])) break; if (_sp > XB_SPIN_CAP) { atomicAdd(&(bar)[XB_TMO], 1u); break; } } } } while (0)

struct XcdBarrier {
    unsigned* bar; unsigned x;
    volatile LAS unsigned* st;
};

__device__ __forceinline__ XcdBarrier xcd_barrier_post(unsigned* bar, volatile LAS unsigned* st) {
    XcdBarrier b; b.bar = bar; b.x = xb_xcc_id(); b.st = st;
    if (threadIdx.x == 0) (void)xb_add(&bar[XB_XCNT(b.x)], 1u);
    return b;
}
__device__ __forceinline__ void xcd_barrier_complete(unsigned* bar, unsigned x, unsigned& nloc, unsigned& nx) {
    const unsigned G = gridDim.x * gridDim.y * gridDim.z;
    unsigned sum, cnt, mine, sp = 0u;
    for (;;) {
        sum = 0u; cnt = 0u; mine = 0u;
#pragma unroll
        for (unsigned j = 0; j < 16; ++j) { const unsigned c = xb_ld(&bar[XB_XCNT(j)]); sum += c; cnt += (c > 0u) ? 1u : 0u; mine = (j == x) ? c : mine; }
        if (sum == G) break;
        __builtin_amdgcn_s_sleep(1);
        if ((++sp & 255u) == 0u) { if (xb_ld(&bar[XB_TMO])) break; if (sp > XB_SPIN_CAP) { atomicAdd(&bar[XB_TMO], 1u); break; } }
    }
    nloc = mine > 0u ? mine : 1u; nx = cnt > 0u ? cnt : 1u;
}

__device__ __forceinline__ void xcd_barrier(const XcdBarrier& b) {
    asm volatile("s_waitcnt vmcnt(0)" ::: "memory");
    __syncthreads();
    if (threadIdx.x == 0) {
        unsigned* bar = b.bar;
        __builtin_amdgcn_s_waitcnt(0);
        unsigned nloc = b.st[0], nx = b.st[1];
        if (nloc == 0u) { xcd_barrier_complete(bar, b.x, nloc, nx); b.st[0] = nloc; b.st[1] = nx; }
        const unsigned old = xb_add(&bar[XB_XSUB(b.x)], 1u);
        const unsigned gen = old / nloc;
        if (old + 1u == (gen + 1u) * nloc) {
            __builtin_amdgcn_fence(__ATOMIC_RELEASE, "agent");
            asm volatile("s_waitcnt vmcnt(0)" ::: "memory");
            const unsigned og = xb_add(&bar[XB_TOP], 1u);
            const unsigned tg = og / nx;
            if (og + 1u == (tg + 1u) * nx) xb_add(&bar[XB_TOPGEN], 1u);
            else XB_SPIN(xb_ld(&bar[XB_TOPGEN]) == tg, bar);
            __builtin_amdgcn_fence(__ATOMIC_ACQUIRE, "agent");
            xb_add(&bar[XB_XGEN(b.x)], 1u);
            asm volatile("s_waitcnt vmcnt(0)" ::: "memory");
        } else {
            XB_SPIN(xb_ld(&bar[XB_XGEN(b.x)]) == gen, bar);
            __builtin_amdgcn_fence(__ATOMIC_ACQUIRE, "agent");
            asm volatile("s_waitcnt vmcnt(0)" ::: "memory");
        }
    }
    __syncthreads();
}

struct Args { const void* in[21]; float* out; unsigned char* ws; int ph_lo, ph_hi; };
constexpr int NPH = 12;

__device__ __forceinline__ void transpose_item(const float* W, int ldw, int k0, int sc0, int nvalid, const float* kscale, bf16_t* WT, int K, int drow0, LAS float* scr, int lane) {
    const int c4 = lane & 7, r8 = lane >> 3;
#pragma unroll
    for (int i = 0; i < 8; ++i) { const int kk = 8 * i + r8; f32x4 v = (f32x4){0.f, 0.f, 0.f, 0.f};
        if (4 * c4 < nvalid) { v = *(const f32x4*)(W + (size_t)(k0 + kk) * ldw + sc0 + 4 * c4); if (kscale) v = v * kscale[k0 + kk]; }
        LAS float* sp = scr + kk * 33 + 4 * c4; sp[0] = v[0]; sp[1] = v[1]; sp[2] = v[2]; sp[3] = v[3]; }
    asm volatile("s_waitcnt lgkmcnt(0)" ::: "memory");
    const int c = lane & 7;
#pragma unroll
    for (int j = 0; j < 4; ++j) { const int n = (lane >> 3) + 8 * j; const LAS float* s = scr + (8 * c) * 33 + n;
        u32x4 o; o.x = cvt_pk_bf16(s[0 * 33], s[1 * 33]); o.y = cvt_pk_bf16(s[2 * 33], s[3 * 33]); o.z = cvt_pk_bf16(s[4 * 33], s[5 * 33]); o.w = cvt_pk_bf16(s[6 * 33], s[7 * 33]);
        *(u32x4*)(WT + (size_t)(drow0 + n) * K + k0 + 8 * c) = o; }
    asm volatile("s_waitcnt lgkmcnt(0)" ::: "memory");
}
__device__ __forceinline__ void win_map(int d0, int& sc0, int& nv) {
    nv = 32;
    if (d0 < 384) sc0 = d0; else if (d0 < 416) sc0 = 640 + (d0 - 384); else if (d0 < 448) { sc0 = 2208; nv = 8; } else if (d0 < 512) { sc0 = 0; nv = 0; }
    else if (d0 < 768) sc0 = 384 + (d0 - 512); else if (d0 < 1280) sc0 = 672 + (d0 - 768); else if (d0 < 1792) sc0 = 1184 + (d0 - 1280);
    else if (d0 < 2816) sc0 = 2216 + (d0 - 1792); else if (d0 < 3840) sc0 = 3240 + (d0 - 2816); else sc0 = 1696 + (d0 - 3840);
}

template <int NR> __device__ __forceinline__ void modnorm_rows(const float* xrow, bf16_t* orow, const float* g, const float* sc, const float* sh, int lane, size_t rstride) {
    f32x4 v[NR][4]; float s[NR];
#pragma unroll
    for (int q = 0; q < NR; ++q)
#pragma unroll
        for (int j = 0; j < 4; ++j) v[q][j] = *((const f32x4*)(xrow + q * rstride) + lane + 64 * j);
#pragma unroll
    for (int q = 0; q < NR; ++q) { s[q] = 0.f;
#pragma unroll
        for (int j = 0; j < 4; ++j) s[q] += (v[q][j][0] * v[q][j][0] + v[q][j][1] * v[q][j][1]) + (v[q][j][2] * v[q][j][2] + v[q][j][3] * v[q][j][3]); }
#pragma unroll
    for (int q = 0; q < NR; ++q) { const float rstd = __builtin_amdgcn_rsqf(wave_sum(s[q]) * (1.0f / D) + EPS);
#pragma unroll
        for (int j = 0; j < 4; ++j) { const int c = 4 * (lane + 64 * j); const f32x4 gg = *(const f32x4*)(g + c), ss = *(const f32x4*)(sc + c), hh = *(const f32x4*)(sh + c);
            const f32x4 y = (v[q][j] * rstd * gg) * (ss + 1.0f) + hh; *(u32x2*)(orow + q * rstride + c) = pack4(y); } }
}
template <int NR> __device__ __forceinline__ void modnorm_rows_c(const float* xrow, bf16_t* orow, const f32x4 (&cA)[4], const f32x4 (&cB)[4], int lane, size_t rstride) {
    f32x4 v[NR][4]; float s[NR];
#pragma unroll
    for (int q = 0; q < NR; ++q)
#pragma unroll
        for (int j = 0; j < 4; ++j) v[q][j] = *((const f32x4*)(xrow + q * rstride) + lane + 64 * j);
#pragma unroll
    for (int q = 0; q < NR; ++q) { s[q] = 0.f;
#pragma unroll
        for (int j = 0; j < 4; ++j) s[q] += (v[q][j][0] * v[q][j][0] + v[q][j][1] * v[q][j][1]) + (v[q][j][2] * v[q][j][2] + v[q][j][3] * v[q][j][3]); }
#pragma unroll
    for (int q = 0; q < NR; ++q) { const float rstd = __builtin_amdgcn_rsqf(wave_sum(s[q]) * (1.0f / D) + EPS);
#pragma unroll
        for (int j = 0; j < 4; ++j) *(u32x2*)(orow + q * rstride + 4 * (lane + 64 * j)) = pack4(v[q][j] * rstd * cA[j] + cB[j]); }
}

template <unsigned MASK> __global__ void __launch_bounds__(NTHR, 2) mk_fwd(Args args) {
    extern __shared__ __attribute__((aligned(16))) unsigned char lds_raw[];
    LAS unsigned char* lds = (LAS unsigned char*)lds_raw;
    cg::grid_group grid = cg::this_grid();
    const int tid = threadIdx.x, lane = tid & 63, wave = __builtin_amdgcn_readfirstlane(tid >> 6);
    const int G = gridDim.x, bid = blockIdx.x;
    const int gw = bid * NWAVES + wave, NGW = G * NWAVES;
    unsigned char* ws = args.ws;
    const float* x = (const float*)args.in[0]; const float* cvec = (const float*)args.in[1]; const int* positions = (const int*)args.in[2];
    const float* w_ada = (const float*)args.in[3]; const float* b_ada = (const float*)args.in[4]; const float* norm_mix_g = (const float*)args.in[5];
    const float* w_in = (const float*)args.in[6]; const float* q_norm_g = (const float*)args.in[7]; const float* w_uq = (const float*)args.in[8];
    const float* kv_norm_g = (const float*)args.in[9]; const float* w_ukv = (const float*)args.in[10]; const float* b_forget = (const float*)args.in[11];
    const float* w_o_mla = (const float*)args.in[12]; const float* w_o_fox = (const float*)args.in[13]; const float* w_out = (const float*)args.in[14];
    const float* norm_ffn_g = (const float*)args.in[15]; const float* w_up = (const float*)args.in[16]; const float* conv_w = (const float*)args.in[17];
    const float* conv_b = (const float*)args.in[18]; const float* w_down = (const float*)args.in[19]; const float* norm_final_g = (const float*)args.in[20];
    float* out = args.out;
    bf16_t *Win_t = (bf16_t*)(ws + WS_WIN), *Wuq_t = (bf16_t*)(ws + WS_WUQ), *Wukv_t = (bf16_t*)(ws + WS_WUKV), *Wom_t = (bf16_t*)(ws + WS_WOM), *Wof_t = (bf16_t*)(ws + WS_WOF),
           *Wout_t = (bf16_t*)(ws + WS_WOUT), *Wup_t = (bf16_t*)(ws + WS_WUP), *Wdn_t = (bf16_t*)(ws + WS_WDN);
    bf16_t *HA = (bf16_t*)(ws + WS_HA), *CQ = (bf16_t*)(ws + WS_CQ), *CKV = (bf16_t*)(ws + WS_CKV), *KR = (bf16_t*)(ws + WS_KR), *FB = (bf16_t*)(ws + WS_FB),
           *FQ = (bf16_t*)(ws + WS_FQ), *FK = (bf16_t*)(ws + WS_FK), *FVt = (bf16_t*)(ws + WS_FVT), *GM = (bf16_t*)(ws + WS_GM), *GF = (bf16_t*)(ws + WS_GF),
           *KN = (bf16_t*)(ws + WS_KN), *VMt = (bf16_t*)(ws + WS_VMT), *OM = (bf16_t*)(ws + WS_OM), *OF = (bf16_t*)(ws + WS_OF), *Qb = (bf16_t*)(ws + WS_Q),
           *T1 = (bf16_t*)(ws + WS_T1), *H2 = (bf16_t*)(ws + WS_H2), *Y = (bf16_t*)(ws + WS_Y), *ACT = (bf16_t*)(ws + WS_ACT);
    float *ADA = (float*)(ws + WS_ADA), *SSQ = (float*)(ws + WS_SSQ), *SSK = (float*)(ws + WS_SSK), *CS = (float*)(ws + WS_CS), *LF = (float*)(ws + WS_LF),
          *HALO = (float*)(ws + WS_HALO), *PART = (float*)(ws + WS_PART), *NF = (float*)(ws + WS_NF), *NRM = (float*)(ws + WS_NRM);
    const int lo = args.ph_lo, hi = args.ph_hi & 0xff, sub = args.ph_hi >> 8;
    const bool fusednorm = (G == 256) && (hi - lo > 1);
#define IN(k) (((MASK >> (k)) & 1u) && lo <= (k) && (k) < hi)
    volatile LAS unsigned* bst = (volatile LAS unsigned*)(lds + 131072 + 64);
    XcdBarrier xbar; xbar.bar = (unsigned*)(ws + WS_BAR); xbar.x = 0; xbar.st = bst;
    if (hi - lo > 1) { if (tid == 0) { bst[0] = 0u; bst[1] = 0u; } __syncthreads(); xbar = xcd_barrier_post((unsigned*)(ws + WS_BAR), bst); }
#define SEAM(k) do { if (IN(k) && IN((k) + 1)) { if (args.ph_hi > 0xFFFF) grid.sync();   xcd_barrier(xbar); } } while (0)

    if (IN(0)) {
#pragma unroll 1
      for (int mprep = 0; mprep < MP_REPS; ++mprep) {
        LAS float* sl = (LAS float*)lds;
        for (int i = tid; i < 2 * D; i += NTHR) sl[i] = siluf_(cvec[i]);
        __syncthreads();
        for (int cgp = bid; cgp < 192; cgp += G) {
            const int c4 = lane & 7, ks = lane >> 3; f32x4 a0 = (f32x4){0.f, 0.f, 0.f, 0.f}, a1 = a0;
#pragma unroll
            for (int i = 0; i < 16; ++i) { const int k = 128 * wave + 8 * i + ks; const f32x4 w = *(const f32x4*)(w_ada + (size_t)k * 6144 + cgp * 32 + 4 * c4); a0 += w * sl[k]; a1 += w * sl[D + k]; }
#pragma unroll
            for (int j = 0; j < 4; ++j) { a0[j] += __shfl_xor(a0[j], 8); a0[j] += __shfl_xor(a0[j], 16); a0[j] += __shfl_xor(a0[j], 32); a1[j] += __shfl_xor(a1[j], 8); a1[j] += __shfl_xor(a1[j], 16); a1[j] += __shfl_xor(a1[j], 32); }
            if (lane < 8) {
#pragma unroll
                for (int j = 0; j < 4; ++j) { sl[2048 + (wave * 2 + 0) * 32 + 4 * lane + j] = a0[j]; sl[2048 + (wave * 2 + 1) * 32 + 4 * lane + j] = a1[j]; } }
            __syncthreads();
            if (tid < 64) { const int bb = tid >> 5, nn = tid & 31; float s = b_ada[cgp * 32 + nn];
#pragma unroll
                for (int w = 0; w < 8; ++w) s += sl[2048 + (w * 2 + bb) * 32 + nn];
                ADA[bb * 6144 + cgp * 32 + nn] = s; }
            __syncthreads();
        }
        __syncthreads();
        for (int i = bid * NTHR + tid; i < T * 16; i += G * NTHR) { const int row = i >> 4, k = i & 15;
            const double rev = (double)positions[row] * INVF[k] * 0.15915494309189535; const double fr = rev - floor(rev);
            const float a = (float)(fr < 0.5 ? fr : fr - 1.0) * 6.283185307179586f;
            CS[i] = __cosf(a); CS[T * 16 + i] = __sinf(a); }
        LAS float* scr = (LAS float*)(lds + 16384 + wave * 8704);
        constexpr int I_IN = (DINP / 32) * 16, I_UQ = 24 * 6, I_UKV = 32 * 4, I_OM = 32 * 8, I_OUT = 32 * 16, I_UP = (NUP / 32) * 16, I_DN = 32 * 44;
        constexpr int NITEMS = I_IN + I_UQ + I_UKV + 2 * I_OM + I_OUT + I_UP + I_DN;
        for (int it = gw; it < NITEMS; it += NGW) {
            int r = it;
            if (r < I_IN) { const int rb = r % (DINP / 32), kb = r / (DINP / 32); int sc0, nv; win_map(32 * rb, sc0, nv); transpose_item(w_in, DIN, 64 * kb, sc0, nv, nullptr, Win_t, D, 32 * rb, scr, lane); continue; } r -= I_IN;
            if (r < I_UQ) { const int rb = r % 24, kb = r / 24; transpose_item(w_uq, 768, 64 * kb, 32 * rb, 32, q_norm_g, Wuq_t, QR, 32 * rb, scr, lane); continue; } r -= I_UQ;
            if (r < I_UKV) { const int rb = r % 32, kb = r / 32; const int d0 = 32 * rb, dd = d0 & 511, sc0 = (dd >> 6) * 128 + (dd & 63) + (d0 >= 512 ? 64 : 0);
                transpose_item(w_ukv, 1024, 64 * kb, sc0, 32, kv_norm_g, Wukv_t, KVR, d0, scr, lane); continue; } r -= I_UKV;
            if (r < I_OM) { const int rb = r % 32, kb = r / 32; transpose_item(w_o_mla, D, 64 * kb, 32 * rb, 32, nullptr, Wom_t, 512, 32 * rb, scr, lane); continue; } r -= I_OM;
            if (r < I_OM) { const int rb = r % 32, kb = r / 32; transpose_item(w_o_fox, D, 64 * kb, 32 * rb, 32, nullptr, Wof_t, 512, 32 * rb, scr, lane); continue; } r -= I_OM;
            if (r < I_OUT) { const int rb = r % 32, kb = r / 32; transpose_item(w_out, D, 64 * kb, 32 * rb, 32, nullptr, Wout_t, D, 32 * rb, scr, lane); continue; } r -= I_OUT;
            if (r < I_UP) { const int rb = r % (NUP / 32), kb = r / (NUP / 32); const int d0 = 32 * rb, tt = d0 >> 8, rr = d0 & 255, sc0 = rr < 128 ? 128 * tt + rr : DFF + 128 * tt + (rr - 128);
                transpose_item(w_up, NUP, 64 * kb, sc0, 32, nullptr, Wup_t, D, d0, scr, lane); continue; } r -= I_UP;
            { const int rb = r % 32, kb = r / 32; transpose_item(w_down, D, 64 * kb, 32 * rb, 32, nullptr, Wdn_t, DFF, 32 * rb, scr, lane); }
        }
          }
    }
    SEAM(0);
    if (IN(1)) {
#pragma unroll 1
      for (int mprep = 0; mprep < MP1_REPS; ++mprep) {
        int curb = -1; f32x4 cA[4], cB[4];
        for (int mp = gw; mp < T / 4; mp += NGW) { const int m = 4 * mp, b = m >> 13;
            if (b != curb) { curb = b; const float* ad = ADA + b * 6144;
#pragma unroll
                for (int j = 0; j < 4; ++j) { const int c = 4 * (lane + 64 * j); cA[j] = *(const f32x4*)(norm_mix_g + c) * (*(const f32x4*)(ad + 1024 + c) + 1.0f); cB[j] = *(const f32x4*)(ad + c); } }
            modnorm_rows_c<4>(x + (size_t)m * D, HA + (size_t)m * D, cA, cB, lane, (size_t)D); }
          }
    }
    SEAM(1);
    if (IN(2)) {
        { pg8::Gemm g{HA, Win_t, T, NPROJ, D}; pg8::StaticOrder S; S.init(T, NPROJ, G, bid);
          EpiProj E{CQ, CKV, KR, FQ, FK, GM, GF, LF, SSQ, SSK, CS, b_forget};
#ifdef SINGLE_UNIT
          S.single = 1;
#pragma unroll 1
          for (int rd = 0; rd * G < S.nwg; ++rd) { S.base = rd; pg8::gemm_phase<EpiProj, pg8::StaticOrder, true, true>(lds, g, S, E); }
#else
          pg8::gemm_phase<EpiProj, pg8::StaticOrder, true, true>(lds, g, S, E);
#endif
        }
#ifndef NO_G2
        { pg8::Gemm g{Win_t + (size_t)NPROJ * D, HA, 512, T, D}; pg8::StaticOrder S; S.init(512, T, G, G - 1 - bid);
          EpiVt E{FVt, nullptr, 0.f};
          pg8::gemm_phase<EpiVt, pg8::StaticOrder, true, true>(lds, g, S, E); }
#endif
    }
    SEAM(2);
    if (IN(3)) {
#pragma unroll 1
      for (int smrep = 0; smrep < SM_REPS; ++smrep) {
        {
            float mq0 = 0.f, mq1 = 0.f, mk0 = 0.f, mk1 = 0.f;
            const bool light = G != 256 || (bid >= 192 && bid < 240); const int lw = G != 256 ? gw : (bid - 192) * NWAVES + wave, LNW = G != 256 ? NGW : 48 * NWAVES;
            if (light)
            for (int r0 = lw * 8; r0 < T; r0 += LNW * 8) { u32x4 qv[8], kv[8];
#pragma unroll
                for (int i = 0; i < 8; ++i) { qv[i] = *(const u32x4*)(FQ + (size_t)(r0 + i) * 512 + 8 * lane); kv[i] = *(const u32x4*)(FK + (size_t)(r0 + i) * 512 + 8 * lane); }
                float sq = 0.f, sk = 0.f;
#pragma unroll
                for (int i = 0; i < 8; ++i) { float a = 0.f, c = 0.f;
#pragma unroll
                    for (int w = 0; w < 4; ++w) { const float q0 = bflo(qv[i][w]), q1 = bfhi(qv[i][w]), k0 = bflo(kv[i][w]), k1 = bfhi(kv[i][w]); a += q0 * q0 + q1 * q1; c += k0 * k0 + k1 * k1; }
                    a += __shfl_xor(a, 1); a += __shfl_xor(a, 2); a += __shfl_xor(a, 4); c += __shfl_xor(c, 1); c += __shfl_xor(c, 2); c += __shfl_xor(c, 4);
                    sq = fmaxf(sq, a); sk = fmaxf(sk, c); }
                if (r0 >> 13) { mq1 = fmaxf(mq1, sq); mk1 = fmaxf(mk1, sk); } else { mq0 = fmaxf(mq0, sq); mk0 = fmaxf(mk0, sk); } }
            if ((lane & 7) == 0) { const int hd = lane >> 3; unsigned* N = (unsigned*)NRM;
                atomicMax(N + hd, __float_as_uint(mq0)); atomicMax(N + 8 + hd, __float_as_uint(mq1)); atomicMax(N + 16 + hd, __float_as_uint(mk0)); atomicMax(N + 24 + hd, __float_as_uint(mk1)); }
        }
#ifndef P3_NO_SCAN
        for (int sq = (G == 256 ? bid - 240 : bid); sq >= 0 && sq < 16; sq += G) {
            const int bb = sq >> 3, hh = sq & 7; LAS double* sd = (LAS double*)lds;
            double v[16]; double run = 0.0;
#pragma unroll
            for (int j = 0; j < 16; ++j) { run += (double)LF[((size_t)bb * SEQ + 16 * tid + j) * 8 + hh]; v[j] = run; }
            sd[tid] = run; __syncthreads();
            if (tid < 64) { double loc[8]; double s = 0.0;
#pragma unroll
                for (int j = 0; j < 8; ++j) { s += sd[tid * 8 + j]; loc[j] = s; }
                double incl = s;
#pragma unroll
                for (int o = 1; o < 64; o <<= 1) { const double up = __shfl_up(incl, o); if (lane >= o) incl += up; }
                const double excl = incl - s;
#pragma unroll
                for (int j = 0; j < 8; ++j) sd[512 + tid * 8 + j] = excl + loc[j]; }
            __syncthreads();
            const double off = tid ? sd[512 + tid - 1] : 0.0;
#pragma unroll
            for (int j = 0; j < 16; ++j) { const double val = -(v[j] + off) * 1.4426950408889634;
                const float f1 = (float)val; const unsigned short b1 = f2bf(f1); const double r1 = val - (double)bf2f(b1);
                const unsigned short b2 = f2bf((float)r1); const double r2 = r1 - (double)bf2f(b2); const unsigned short b3 = f2bf((float)r2);
                *(u32x4*)(FB + (((size_t)bb * SEQ + 16 * tid + j) * 8 + hh) * 8) = (u32x4){(unsigned)b1 | ((unsigned)b2 << 16), (unsigned)b3, 0u, 0u};
                NF[((size_t)bb * SEQ + 16 * tid + j) * 8 + hh] = f1; }
            __syncthreads();
        }
#endif
#ifndef P3_NO_Q
        { pg8::Gemm g{CQ, Wuq_t, T, 768, QR}; pg8::StaticOrder S; S.init(T, 768, G, bid); EpiQ E{Qb, SSQ, CS};
          pg8::gemm_phase<EpiQ, pg8::StaticOrder, true, true>(lds, g, S, E); }
#endif
#ifndef P3_NO_KN
        { pg8::Gemm g{CKV, Wukv_t, T, 512, KVR}; pg8::StaticOrder S; S.init(T, 512, G, (bid + 64) % G); EpiKN E{KN, SSK};
          pg8::gemm_phase<EpiKN, pg8::StaticOrder, true, true>(lds, g, S, E); }
#endif
#ifndef P3_NO_VMT
        { pg8::Gemm g{Wukv_t + (size_t)512 * KVR, CKV, 512, T, KVR}; pg8::StaticOrder S; S.init(512, T, G, (bid + G - 64) % G); EpiVt E{VMt, SSK, 1.0f / KVR};
          pg8::gemm_phase<EpiVt, pg8::StaticOrder, true, true>(lds, g, S, E); }
#endif
          }
    }
    SEAM(3);
    if (IN(4)) {
#ifndef ATT_REPS
#define ATT_REPS 1
#endif
        {
            volatile LAS unsigned* slot = (volatile LAS unsigned*)(lds + 131072 + 128);
            if (wave >= 4) __builtin_amdgcn_s_setprio(1);
            unsigned* qctr = (unsigned*)(ws + WS_NRM + 128);
#pragma unroll 1
            for (;;) {
                if (tid == 0) slot[0] = __hip_atomic_fetch_add(qctr, 1u, __ATOMIC_RELAXED, __HIP_MEMORY_SCOPE_AGENT);
                __syncthreads();
                const unsigned un = slot[0];
                __syncthreads();
                if (un >= 1024u) break;
                const int qb = 31 - (int)(un >> 5), w = (int)(un & 31), br = w >> 4, bh = w & 15, bb = bh >> 3, hh = bh & 7;
                if (br == 0) attn_unit<6, 12, 208>(lds, bb, hh, qb, Qb, 768, hh * 96, KN, 512, hh * 64, KR, 32, 0, VMt, hh * 64, OM, hh * 64, 0);
                else {
                    const float bound = 2.02f * sqrtf(NRM[bb * 8 + hh] * NRM[16 + bb * 8 + hh]) + 32.0f, lim = NF[((size_t)bb * SEQ + 256 * qb) * 8 + hh] - bound;
                    const int nit = 2 * qb + 2; const bool skip = lane < nit && NF[((size_t)bb * SEQ + 128 * lane + 127) * 8 + hh] <= lim;
                    int it0 = __builtin_amdgcn_readfirstlane(__popcll(__ballot(skip))); it0 = (it0 < nit - 2 ? it0 : nit - 2) & ~1;
                    attn_unit<5, 9, 144>(lds, bb, hh, qb, FQ, 512, hh * 64, FK, 512, hh * 64, FB, 64, hh * 8, FVt, hh * 64, OF, hh * 64, it0); }
                __syncthreads();
            }
            __builtin_amdgcn_s_setprio(0);
        }
    }
    SEAM(4);
    if (IN(5)) {
#pragma unroll 1
      for (int smrep = 0; smrep < SM_REPS; ++smrep) {
        { pg8::Gemm g{OM, Wom_t, T, D, 512}; PairOrder S; S.S0.init(T, D, G, bid); EpiGate2 E{GM, GF, Y};
          pg8::gemm_phase<EpiGate2, PairOrder, true, true>(lds, g, S, E); }

          }
    }
    SEAM(5);
    if (IN(6)) {
#pragma unroll 1
      for (int smrep = 0; smrep < SM_REPS; ++smrep) {
        pg8::Gemm g{Y, Wout_t, T, D, D}; pg8::StaticOrder S; S.init(T, D, G, bid);
        if (fusednorm) { EpiResNorm<false> E{x, out, ADA + 2048, (float*)(ws + WS_SS1), (unsigned*)(ws + WS_CNT), norm_ffn_g, ADA + 4096, ADA + 3072, H2};
            pg8::gemm_phase<EpiResNorm<false>, pg8::StaticOrder, false, true>(lds, g, S, E); }
        else { EpiRes E{x, out, ADA + 2048};
            pg8::gemm_phase<EpiRes, pg8::StaticOrder, true, true>(lds, g, S, E); }
          }
    }
    SEAM(6);
    if (IN(7) && !fusednorm) {
#pragma unroll 1
      for (int mprep = 0; mprep < MP_REPS; ++mprep) {
        for (int mp = gw; mp < T / 2; mp += NGW) { const int m = 2 * mp; const float* ad = ADA + (m >> 13) * 6144; modnorm_rows<2>(out + (size_t)m * D, H2 + (size_t)m * D, norm_ffn_g, ad + 4096, ad + 3072, lane, (size_t)D); }
          }
    }
    if (!fusednorm) SEAM(7);
    if (IN(8)) {
#pragma unroll 1
      for (int rep8 = 0; rep8 < P8_REPS; ++rep8) {
        pg8::Gemm g{H2, Wup_t, T, NUP, D}; pg8::StaticOrder S; S.init(T, NUP, G, bid); EpiConv E{ACT, HALO, PART, conv_w, conv_b};
        pg8::gemm_phase<EpiConv, pg8::StaticOrder, true, true>(lds, g, S, E);
      }
    }
    SEAM(8);
    if (IN(9)) {
        for (int i = bid * NTHR + tid; i < 256 * 2 * (DFF / 4); i += G * NTHR) {
            const int c4 = i % (DFF / 4), rr = (i / (DFF / 4)) & 1, grp = i / (2 * (DFF / 4)), ng = 4 * c4;
            f32x4 cgv = *(const f32x4*)(PART + ((size_t)grp * 2 + rr) * NUP + ng), cvv = *(const f32x4*)(PART + ((size_t)grp * 2 + rr) * NUP + DFF + ng);
            if (grp & 127) {
                const float* H = HALO + (size_t)(grp - 1) * 2 * NUP;
                const f32x4 wg0 = *(const f32x4*)(conv_w + ng), wg1 = *(const f32x4*)(conv_w + NUP + ng), wv0 = *(const f32x4*)(conv_w + DFF + ng), wv1 = *(const f32x4*)(conv_w + NUP + DFF + ng);
                const f32x4 hg0 = *(const f32x4*)(H + ng), hg1 = *(const f32x4*)(H + NUP + ng), hv0 = *(const f32x4*)(H + DFF + ng), hv1 = *(const f32x4*)(H + NUP + DFF + ng);
                if (rr == 0) { cgv += wg0 * hg0 + wg1 * hg1; cvv += wv0 * hv0 + wv1 * hv1; }
                else { cgv += wg0 * hg1; cvv += wv0 * hv1; }
            }
            f32x4 a;
#pragma unroll
            for (int j = 0; j < 4; ++j) a[j] = siluf_(cgv[j]) * cvv[j];
            *(u32x2*)(ACT + (size_t)(64 * grp + rr) * DFF + ng) = pack4(a);
        }
    }
    SEAM(9);
    if (IN(10)) {
        pg8::Gemm g{ACT, Wdn_t, T, D, DFF}; pg8::StaticOrder S; S.init(T, D, G, bid);
        if (fusednorm) { EpiResNorm<true> E{out, out, ADA + 5120, (float*)(ws + WS_SS2), (unsigned*)(ws + WS_CNT) + 64 * 64, norm_final_g, nullptr, nullptr, nullptr};
            pg8::gemm_phase<EpiResNorm<true>, pg8::StaticOrder, false, true>(lds, g, S, E); }
        else { EpiRes E{out, out, ADA + 5120};
            pg8::gemm_phase<EpiRes, pg8::StaticOrder, true, true>(lds, g, S, E); }
    }
    if (!fusednorm) SEAM(10);
    if (IN(11) && !fusednorm) {
        for (int mp = gw; mp < T / 2; mp += NGW) { float* row = out + (size_t)(2 * mp) * D; f32x4 v[2][4]; float s[2];
#pragma unroll
            for (int q = 0; q < 2; ++q)
#pragma unroll
                for (int j = 0; j < 4; ++j) v[q][j] = *((const f32x4*)(row + q * D) + lane + 64 * j);
#pragma unroll
            for (int q = 0; q < 2; ++q) { s[q] = 0.f;
#pragma unroll
                for (int j = 0; j < 4; ++j) s[q] += (v[q][j][0] * v[q][j][0] + v[q][j][1] * v[q][j][1]) + (v[q][j][2] * v[q][j][2] + v[q][j][3] * v[q][j][3]); }
#pragma unroll
            for (int q = 0; q < 2; ++q) { const float rstd = __builtin_amdgcn_rsqf(wave_sum(s[q]) * (1.0f / D) + EPS);
#pragma unroll
                for (int j = 0; j < 4; ++j) { const f32x4 gg = *((const f32x4*)norm_final_g + lane + 64 * j); *((f32x4*)(row + q * D) + lane + 64 * j) = v[q][j] * rstd * gg; } } }
    }
#undef IN
#undef SEAM
}


#ifdef DBG_STOP
__global__ void dump_kernel(float* out, const unsigned short* src, size_t ne, const unsigned short* src2) {
    const size_t N = (size_t)T * D;
    for (size_t i = (size_t)blockIdx.x * blockDim.x + threadIdx.x; i < N; i += (size_t)gridDim.x * blockDim.x)
        out[i] = i < ne ? bf2f(src[i]) : (src2 && i - ne < ne ? bf2f(src2[i - ne]) : 0.f);
}
#endif
#ifndef MK_ONE_LAUNCH
#define MK_ONE_LAUNCH 1
#endif
extern "C" void kernel_launch(void* const* d_in, const int* in_sizes, int n_in, void* d_out, int out_size, void* d_ws, size_t ws_size, hipStream_t stream) {
    static int grid = 0;
    const void* kfn = (const void*)mk_fwd<0xFFFu>;
    if (grid == 0) {
        int dev = 0, cus = 0, per_cu = 0;
        (void)hipGetDevice(&dev); (void)hipDeviceGetAttribute(&cus, hipDeviceAttributeMultiprocessorCount, dev);
        if (hipFuncSetAttribute(kfn, hipFuncAttributeMaxDynamicSharedMemorySize, LDS_BYTES) != hipSuccess) { fprintf(stderr, "hipFuncSetAttribute failed\n"); grid = -1; return; }
        if (hipOccupancyMaxActiveBlocksPerMultiprocessor(&per_cu, kfn, NTHR, LDS_BYTES) != hipSuccess || per_cu < 1) { fprintf(stderr, "occupancy query: %d\n", per_cu); per_cu = 1; }
        (void)hipGetLastError();
        grid = cus * per_cu;
        fprintf(stderr, "mk_fwd: grid %d (cus %d x %d), ws %zu\n", grid, cus, per_cu, ws_size);
    }
    if (grid < 0) return;
    (void)hipMemsetAsync((unsigned char*)d_ws + ZERO_OFF, 0, ZERO_BYTES, stream);
    Args a{};
    for (int i = 0; i < 21; ++i) a.in[i] = d_in[i];
    a.out = (float*)d_out; a.ws = (unsigned char*)d_ws;
#if MK_ONE_LAUNCH
    a.ph_lo = 0; a.ph_hi = NPH;
    void* kargs[] = {&a};
    hipError_t e = hipLaunchCooperativeKernel(kfn, dim3(grid), dim3(NTHR), kargs, LDS_BYTES, stream);
    if (e != hipSuccess) fprintf(stderr, "cooperative launch failed: %s (grid %d)\n", hipGetErrorString(e), grid);
#else
#define MK_L(ph) do { a.ph_lo = ph; a.ph_hi = ph + 1; (void)hipFuncSetAttribute((const void*)mk_fwd<(1u << ph)>, hipFuncAttributeMaxDynamicSharedMemorySize, LDS_BYTES); hipLaunchKernelGGL(mk_fwd<(1u << ph)>, dim3(grid), dim3(NTHR), LDS_BYTES, stream, a); } while (0)
#ifdef DBG_STOP
#define MK_LD(ph) do { if (ph < DBG_STOP) MK_L(ph); } while (0)
#ifdef P5_ONLY_G7
#define P5_ONLY 1
#else
#define P5_ONLY 0
#endif
#ifdef P5_SPLIT
#undef MK_LD
#define MK_LD(ph) do { if (ph < DBG_STOP) { if (ph == 5) { (void)hipFuncSetAttribute((const void*)mk_fwd<32u>, hipFuncAttributeMaxDynamicSharedMemorySize, LDS_BYTES); a.ph_lo = 5; a.ph_hi = 6 | 0x100; hipLaunchKernelGGL(mk_fwd<32u>, dim3(grid), dim3(NTHR), LDS_BYTES, stream, a); a.ph_hi = 6 | 0x200; if (!P5_ONLY) hipLaunchKernelGGL(mk_fwd<32u>, dim3(grid), dim3(NTHR), LDS_BYTES, stream, a); } else MK_L(ph); } } while (0)
#endif
    MK_LD(0); MK_LD(1); MK_LD(2); MK_LD(3); MK_LD(4); MK_LD(5); MK_LD(6); MK_LD(7); MK_LD(8); MK_LD(9); MK_LD(10); MK_LD(11);
#ifdef DUMP_OFF
    hipLaunchKernelGGL(dump_kernel, dim3(2048), dim3(256), 0, stream, (float*)d_out, (const unsigned short*)((const unsigned char*)d_ws + (size_t)(DUMP_OFF) * MiB), (size_t)(DUMP_MIB) * MiB / 2,
#ifdef DUMP_OFF2
        (const unsigned short*)((const unsigned char*)d_ws + (size_t)(DUMP_OFF2) * MiB));
#else
        (const unsigned short*)nullptr);
#endif
#endif
#else
    MK_L(0); MK_L(1); MK_L(2); MK_L(3); MK_L(4); MK_L(5); MK_L(6); MK_L(7); MK_L(8); MK_L(9); MK_L(10); MK_L(11);
#endif
#undef MK_L
#endif
}
```

```cpp
#include <hip/hip_runtime.h>
#include <hip/hip_cooperative_groups.h>
#include <cstdio>
#include <cstdint>
#include <cmath>
namespace cg = cooperative_groups;
namespace pg8 {
#define PG8_LAS __attribute__((address_space(3)))
typedef unsigned short bf16_t;
typedef short bf16x8 __attribute__((ext_vector_type(8)));
typedef float f32x4 __attribute__((ext_vector_type(4)));
typedef unsigned u32x4 __attribute__((ext_vector_type(4)));
constexpr int BM = 256, BK = 64, HALF = 128, HTB = HALF * BK * 2  , STAGE_BYTES = 8 * HTB, NXCD = 8, WGM = 8;

__host__ __device__ __forceinline__ int lds_byte(int r, int c) { const int st = (r >> 4) * 2 + (c >> 5), rr = r & 15, cc = c & 31, ob = rr * 64 + cc * 2; return st * 1024 + (ob ^ (((ob >> 9) & 1) << 5)); }
__host__ __device__ __forceinline__ void stage_rc(int b, int& R, int& C) { const int st = b / 1024, sb = b % 1024, swz = sb ^ (((sb >> 9) & 1) << 5); R = (st >> 1) * 16 + swz / 64; C = (st & 1) * 32 + (swz % 64) / 2; }
__host__ __device__ __forceinline__ int perm32(int rho) { const int n = rho >> 4, i = rho & 15; return 8 * (i >> 2) + 4 * n + (i & 3); }

struct Unit { int pm, pn; };
struct Gemm { const bf16_t* A; const bf16_t* Bt; int M, N, K; };

struct StaticOrder {
    int nM, nN, nwg, G, c, base = 0, single = 0, off = 0;
    __host__ __device__ void init(int M, int N, int G_, int c_) { nM = M / BM; nN = N / BM; nwg = nM * nN; G = G_; c = c_; }
    __host__ __device__ bool next(int i, Unit& u) const {
        if (single && i > 0) return false;
        const long L = (long)(i + base) * G + c; if (L >= nwg) return false;
        int wgid = (int)L; { const int q = nwg / NXCD, r = nwg % NXCD, xcd = wgid % NXCD, off = wgid / NXCD; wgid = (xcd < r ? xcd * (q + 1) : r * (q + 1) + (xcd - r) * q) + off; }
        wgid += off;
        const int nig = WGM * nN, gid = wgid / nig, fm = gid * WGM, gsz = (nM - fm) < WGM ? (nM - fm) : WGM;
        u.pm = fm + ((wgid % nig) % gsz); u.pn = (wgid % nig) / gsz; return true;
    }
    __device__ __forceinline__ void a_ready(const Unit&) const {}
    __device__ __forceinline__ void done(const Unit&) const {}
};

__device__ __forceinline__ unsigned cvt_pk_bf16(float lo, float hi) { unsigned r; asm volatile("v_cvt_pk_bf16_f32 %0, %1, %2" : "=v"(r) : "v"(lo), "v"(hi)); return r; }
typedef float f32x2 __attribute__((ext_vector_type(2)));
template <class E, class = void> struct epi_keep { static constexpr bool value = false; };
template <class E> struct epi_keep<E, decltype((void)E::KEEP)> { static constexpr bool value = E::KEEP; };
template <class Epi, class Sched, bool ALIGN_EPI = false, bool SP2 = false>
__device__ __forceinline__ void gemm_phase(PG8_LAS unsigned char* lds, const Gemm g, const Sched& S, const Epi& E) {
    int tid_ = threadIdx.x; asm volatile("" : "+v"(tid_));
    const int tid = tid_, wid = __builtin_amdgcn_readfirstlane(tid >> 6), lane = tid & 63, wr = wid >> 2, wc = wid & 3, fr = lane & 15, fq = lane >> 4;
    int K_ = g.K; asm volatile("" : "+s"(K_));
    const int K = K_, nt = K / BK;
    unsigned voffA[2], voffB[2];
#pragma unroll
    for (int i = 0; i < 2; ++i) { int R, C; stage_rc(tid * 16 + i * 8192, R, C); const int Rb = Epi::PERM ? ((R & ~31) + perm32(R & 31)) : R;
        voffA[i] = (unsigned)(R * K + C) * 2u; voffB[i] = (unsigned)(Rb * K + C) * 2u; }
    const size_t kstep = (size_t)(BK * 2);
    const size_t hstep = (size_t)HALF * K * 2;
    const size_t tstep = 2 * hstep;
    const unsigned ldsw = (unsigned)wid * 1024u;
    const int aoff = lds_byte(wr * 64 + fr, fq * 8), boff = lds_byte(wc * 32 + fr, fq * 8);
#define PG8_SA(b, h) (((b) * 2 + (h)) * HTB)
#define PG8_SB(b, h) ((4 + (b) * 2 + (h)) * HTB)
#define PG8_STAGE(bufoff, gbase, voff) do { _Pragma("unroll") for (int _i = 0; _i < 2; ++_i) \
        __builtin_amdgcn_global_load_lds((const unsigned*)((const char*)(gbase) + (voff)[_i]), (PG8_LAS unsigned*)(lds + (bufoff) + ldsw + _i * 8192), 16, 0, 0); } while (0)
#define PG8_LDA(dst, b, h) do { _Pragma("unroll") for (int m = 0; m < 4; ++m) _Pragma("unroll") for (int k = 0; k < 2; ++k) dst[m][k] = *(const PG8_LAS bf16x8*)(lds + PG8_SA(b, h) + aoff + m * 2048 + k * 1024); } while (0)
#define PG8_LDB(dst, b, h) do { _Pragma("unroll") for (int n = 0; n < 2; ++n) _Pragma("unroll") for (int k = 0; k < 2; ++k) dst[n][k] = *(const PG8_LAS bf16x8*)(lds + PG8_SB(b, h) + boff + n * 2048 + k * 1024); } while (0)
#define PG8_MMA(ai, bj, At, Bt) do { __builtin_amdgcn_s_setprio(1); _Pragma("unroll") for (int m = 0; m < 4; ++m) _Pragma("unroll") for (int n = 0; n < 2; ++n) _Pragma("unroll") for (int k = 0; k < 2; ++k) \
        acc[ai][bj][m][n] = __builtin_amdgcn_mfma_f32_16x16x32_bf16(Bt[n][k], At[m][k], acc[ai][bj][m][n], 0, 0, 0); __builtin_amdgcn_s_setprio(0); } while (0)
#define PG8_WAIT_V(n) asm volatile("s_waitcnt vmcnt(" #n ")" ::: "memory")
#define PG8_WAIT_L(n) asm volatile("s_waitcnt lgkmcnt(" #n ")" ::: "memory")
#define PG8_BAR __builtin_amdgcn_s_barrier()
#define PG8_SCHED __builtin_amdgcn_sched_barrier(0)
    Unit cur, nxt; int ui = 0;
    if (!S.next(0, cur)) return;
    f32x4 acc[2][2][4][2];
#pragma unroll
    for (int a = 0; a < 2; ++a)
#pragma unroll
        for (int b = 0; b < 2; ++b)
#pragma unroll
            for (int m = 0; m < 4; ++m)
#pragma unroll
                for (int n = 0; n < 2; ++n) acc[a][b][m][n] = (f32x4){0.f, 0.f, 0.f, 0.f};
    bf16x8 At[4][2], B0[2][2], B1[2][2];
    const char* cA = (const char*)g.A + (size_t)cur.pm * tstep; const char* cB = (const char*)g.Bt + (size_t)cur.pn * tstep;
    S.a_ready(cur);
    if constexpr (SP2) {
        PG8_STAGE(PG8_SB(0, 0), cB, voffB); PG8_STAGE(PG8_SB(0, 1), cB + hstep, voffB); PG8_STAGE(PG8_SA(0, 0), cA, voffA); PG8_STAGE(PG8_SA(0, 1), cA + hstep, voffA);
        if (wr == 1) PG8_BAR;
        PG8_WAIT_V(2); PG8_BAR;
        PG8_STAGE(PG8_SB(1, 0), cB + kstep, voffB); PG8_STAGE(PG8_SA(1, 0), cA + kstep, voffA); PG8_STAGE(PG8_SB(1, 1), cB + hstep + kstep, voffB);
        PG8_WAIT_V(6); PG8_BAR;
    } else {
        PG8_STAGE(PG8_SB(0, 0), cB, voffB); PG8_STAGE(PG8_SA(0, 0), cA, voffA); PG8_STAGE(PG8_SB(0, 1), cB + hstep, voffB); PG8_STAGE(PG8_SA(0, 1), cA + hstep, voffA);
        if (wr == 1) PG8_BAR;
        PG8_WAIT_V(4); PG8_BAR;
        PG8_STAGE(PG8_SB(1, 0), cB + kstep, voffB); PG8_STAGE(PG8_SA(1, 0), cA + kstep, voffA); PG8_STAGE(PG8_SB(1, 1), cB + hstep + kstep, voffB);
        PG8_WAIT_V(6); PG8_BAR;
    }
    for (;;) {
        const bool has_next = S.next(ui + 1, nxt);
        const char* nA = has_next ? (const char*)g.A + (size_t)nxt.pm * tstep : cA; const char* nB = has_next ? (const char*)g.Bt + (size_t)nxt.pn * tstep : cB;
        for (int t = 0; t < nt; t += 2) {
            const bool last = (t == nt - 2);
            const char* a1 = cA + (size_t)(t + 1) * kstep;
            const char* a2 = last ? nA : cA + (size_t)(t + 2) * kstep; const char* b2 = last ? nB : cB + (size_t)(t + 2) * kstep;
            const char* a3 = a2 + kstep; const char* b3 = b2 + kstep;
            if (last && has_next) S.a_ready(nxt);
            if constexpr (SP2) {
            PG8_LDB(B0, 0, 0); PG8_LDB(B1, 0, 1); PG8_SCHED; PG8_LDA(At, 0, 0); PG8_STAGE(PG8_SA(1, 1), a1 + hstep, voffA);
            PG8_WAIT_V(8); PG8_WAIT_L(0); PG8_BAR; PG8_MMA(0, 0, At, B0); PG8_MMA(0, 1, At, B1); PG8_BAR; PG8_SCHED;
            PG8_LDA(At, 0, 1); PG8_STAGE(PG8_SB(0, 0), b2, voffB); PG8_STAGE(PG8_SB(0, 1), b2 + hstep, voffB); PG8_STAGE(PG8_SA(0, 0), a2, voffA);
            PG8_WAIT_V(8); PG8_WAIT_L(0); PG8_BAR; PG8_MMA(1, 0, At, B0); PG8_MMA(1, 1, At, B1); PG8_BAR; PG8_SCHED;
            PG8_LDB(B0, 1, 0); PG8_LDB(B1, 1, 1); PG8_SCHED; PG8_LDA(At, 1, 0); PG8_STAGE(PG8_SA(0, 1), a2 + hstep, voffA);
            PG8_WAIT_V(8); PG8_WAIT_L(0); PG8_BAR; PG8_MMA(0, 0, At, B0); PG8_MMA(0, 1, At, B1); PG8_BAR; PG8_SCHED;
            PG8_LDA(At, 1, 1); PG8_STAGE(PG8_SB(1, 0), b3, voffB); PG8_STAGE(PG8_SB(1, 1), b3 + hstep, voffB); PG8_STAGE(PG8_SA(1, 0), a3, voffA);
            PG8_WAIT_V(8); PG8_WAIT_L(0); PG8_BAR; PG8_MMA(1, 0, At, B0); PG8_MMA(1, 1, At, B1); PG8_BAR; PG8_SCHED;
            } else {
            PG8_LDB(B0, 0, 0); PG8_SCHED; PG8_LDA(At, 0, 0); PG8_STAGE(PG8_SA(1, 1), a1 + hstep, voffA);
            PG8_WAIT_L(8); PG8_BAR; PG8_WAIT_L(0); PG8_MMA(0, 0, At, B0); PG8_BAR; PG8_SCHED;
            PG8_LDB(B1, 0, 1); PG8_STAGE(PG8_SB(0, 0), b2, voffB);
            PG8_BAR; PG8_WAIT_L(0); PG8_MMA(0, 1, At, B1); PG8_BAR;
            PG8_LDA(At, 0, 1); PG8_STAGE(PG8_SA(0, 0), a2, voffA);
            PG8_BAR; PG8_WAIT_L(0); PG8_MMA(1, 0, At, B0); PG8_BAR; PG8_SCHED;
            PG8_STAGE(PG8_SB(0, 1), b2 + hstep, voffB);
            PG8_WAIT_V(6); PG8_BAR; PG8_MMA(1, 1, At, B1); PG8_BAR;
            PG8_LDB(B0, 1, 0); PG8_SCHED; PG8_LDA(At, 1, 0); PG8_STAGE(PG8_SA(0, 1), a2 + hstep, voffA);
            PG8_WAIT_L(8); PG8_BAR; PG8_WAIT_L(0); PG8_MMA(0, 0, At, B0); PG8_BAR; PG8_SCHED;
            PG8_LDB(B1, 1, 1); PG8_STAGE(PG8_SB(1, 0), b3, voffB);
            PG8_BAR; PG8_WAIT_L(0); PG8_MMA(0, 1, At, B1); PG8_BAR;
            PG8_LDA(At, 1, 1); PG8_STAGE(PG8_SA(1, 0), a3, voffA);
            PG8_BAR; PG8_WAIT_L(0); PG8_MMA(1, 0, At, B0); PG8_BAR; PG8_SCHED;
            PG8_STAGE(PG8_SB(1, 1), b3 + hstep, voffB);
            PG8_WAIT_V(6); PG8_BAR; PG8_MMA(1, 1, At, B1); PG8_BAR;
            }
        }
        if constexpr (ALIGN_EPI) { if (wr == 0) PG8_BAR; }
        if constexpr (!Epi::AFTER_DRAIN) { E(acc, cur, wr, wc, fr, fq); S.done(cur); }
        if (!has_next) break;
        bool keep_acc = false; if constexpr (epi_keep<Epi>::value) keep_acc = E.keep_acc(cur);
        if (!keep_acc)
#pragma unroll
        for (int a = 0; a < 2; ++a)
#pragma unroll
            for (int b = 0; b < 2; ++b)
#pragma unroll
                for (int m = 0; m < 4; ++m)
#pragma unroll
                    for (int n = 0; n < 2; ++n) acc[a][b][m][n] = (f32x4){0.f, 0.f, 0.f, 0.f};
        cur = nxt; cA = nA; cB = nB; ++ui;
        if constexpr (ALIGN_EPI) { if (wr == 1) PG8_BAR; }
    }
    PG8_WAIT_V(0);
    if constexpr (!ALIGN_EPI) { if (wr == 0) PG8_BAR; }
    PG8_BAR;
    if constexpr (Epi::AFTER_DRAIN) { E.fused(acc, cur, wr, wc, fr, fq, lds, wid, lane); S.done(cur); }
#undef PG8_SA
#undef PG8_SB
#undef PG8_STAGE
#undef PG8_LDA
#undef PG8_LDB
#undef PG8_MMA
#undef PG8_WAIT_V
#undef PG8_WAIT_L
#undef PG8_BAR
#undef PG8_SCHED
}
}
#ifndef MP_REPS
#define MP_REPS 1
#endif
#ifndef MP1_REPS
#define MP1_REPS 1
#endif
#ifndef SM_REPS
#define SM_REPS 1
#endif
#ifndef P8_REPS
#define P8_REPS 1
#endif
#define LAS __attribute__((address_space(3)))
using pg8::bf16_t; using pg8::bf16x8; using pg8::f32x4; using pg8::u32x4; using pg8::Unit;
typedef float f32x2_t __attribute__((ext_vector_type(2))); typedef __bf16 bf16x2_t __attribute__((ext_vector_type(2)));
__device__ __forceinline__ unsigned cvt_pk_bf16(float lo, float hi) { f32x2_t v = {lo, hi}; bf16x2_t b = __builtin_convertvector(v, bf16x2_t); return __builtin_bit_cast(unsigned, b); }
typedef float f32x16 __attribute__((ext_vector_type(16)));
typedef unsigned u32x2 __attribute__((ext_vector_type(2)));

constexpr int NWAVES = 8, NTHR = 512;
constexpr int BATCH = 2, SEQ = 8192, T = BATCH * SEQ, D = 1024;
constexpr int DIN = 4264, DINP = 4352, NPROJ = 3840;
constexpr int QR = 384, KVR = 256, DFF = 2816, NUP = 5632;
constexpr float EPS = 1e-6f;
constexpr float LOG2E = 1.4426950408889634f;
constexpr float MLA_C = 0.10206207261596577f * LOG2E;
constexpr float FOX_C = 0.125f * LOG2E;
constexpr size_t MiB = 1u << 20;
constexpr size_t WS_WIN = 0, WS_WUQ = 9 * MiB, WS_WUKV = 10 * MiB, WS_WOM = 11 * MiB, WS_WOF = 12 * MiB, WS_WOUT = 13 * MiB, WS_WUP = 15 * MiB, WS_WDN = 26 * MiB;
constexpr size_t WS_HA = 32 * MiB;
constexpr size_t WS_CQ = 64 * MiB, WS_CKV = 76 * MiB, WS_KR = 84 * MiB;
constexpr size_t WS_SMALL = 85 * MiB;
constexpr size_t WS_ADA = WS_SMALL, WS_SSQ = WS_SMALL + 65536, WS_SSK = WS_SMALL + 2 * 65536, WS_BAR = WS_SMALL + 3 * 65536, WS_SS1 = WS_BAR + 16384, WS_SS2 = WS_SS1 + 65536, WS_CNT = WS_SS2 + 65536, ZERO_OFF = WS_SSQ, WS_NRM = WS_CNT + 32768, ZERO_BYTES = 2 * 65536 + 16384 + 2 * 65536 + 32768 + 256;
constexpr size_t WS_CS = 86 * MiB;
constexpr size_t WS_LF = 88 * MiB;
constexpr size_t WS_FB = 89 * MiB;
constexpr size_t WS_NF = 91 * MiB;
constexpr size_t WS_FQ = 96 * MiB, WS_FK = 112 * MiB, WS_FVT = 128 * MiB, WS_GM = 144 * MiB, WS_GF = 176 * MiB;
constexpr size_t WS_KN = 208 * MiB, WS_VMT = 224 * MiB, WS_OM = 240 * MiB, WS_OF = 64 * MiB;
constexpr size_t WS_Q = WS_HA, WS_T1 = WS_HA, WS_H2 = WS_HA, WS_Y = 96 * MiB, WS_ACT = 96 * MiB, WS_HALO = 184 * MiB, WS_PART = 195 * MiB;
constexpr int LDS_BYTES = 135168;

__device__ const double INVF[16] = {1.0, 0.5623413251903491, 0.31622776601683794, 0.1778279410038923, 0.1, 0.05623413251903491, 0.03162277660168379, 0.01778279410038923, 0.01, 0.005623413251903491, 0.0031622776601683794, 0.0017782794100389228, 0.001, 0.0005623413251903491, 0.00031622776601683794, 0.00017782794100389227};

__device__ __forceinline__ float bf2f(unsigned short b) { return __builtin_bit_cast(float, (unsigned)b << 16); }
__device__ __forceinline__ float bflo(unsigned w) { return __builtin_bit_cast(float, w << 16); }
__device__ __forceinline__ float bfhi(unsigned w) { return __builtin_bit_cast(float, w & 0xffff0000u); }
__device__ __forceinline__ unsigned short f2bf(float f) { return (unsigned short)(cvt_pk_bf16(f, 0.f) & 0xffffu); }
__device__ __forceinline__ u32x2 pack4(f32x4 v) { u32x2 w; w.x = cvt_pk_bf16(v[0], v[1]); w.y = cvt_pk_bf16(v[2], v[3]); return w; }
__device__ __forceinline__ void st_pair16(bf16_t* p0, u32x2 w0, u32x2 w1, int fq) {
    const auto sx = __builtin_amdgcn_permlane16_swap(w0.x, w1.x, false, false), sy = __builtin_amdgcn_permlane16_swap(w0.y, w1.y, false, false);
    *(u32x4*)(p0 + ((fq & 1) ? 12 : 0)) = (u32x4){sx[0], sy[0], sx[1], sy[1]};
}
__device__ __forceinline__ void ld_pair16(const bf16_t* p0, int fq, u32x2& w0, u32x2& w1) {
    const u32x4 t = *(const u32x4*)(p0 + ((fq & 1) ? 12 : 0));
    const auto sx = __builtin_amdgcn_permlane16_swap(t.x, t.z, false, false), sy = __builtin_amdgcn_permlane16_swap(t.y, t.w, false, false);
    w0 = (u32x2){sx[0], sy[0]}; w1 = (u32x2){sx[1], sy[1]};
}
__device__ __forceinline__ void st_pair16_if(bf16_t* p0, u32x2 w0, u32x2 w1, int fq, bool doit) {
    const auto sx = __builtin_amdgcn_permlane16_swap(w0.x, w1.x, false, false), sy = __builtin_amdgcn_permlane16_swap(w0.y, w1.y, false, false);
    if (doit) *(u32x4*)(p0 + ((fq & 1) ? 12 : 0)) = (u32x4){sx[0], sy[0], sx[1], sy[1]};
}
__device__ __forceinline__ float wave_sum(float v) {
#pragma unroll
    for (int o = 1; o < 64; o <<= 1) v += __shfl_xor(v, o);
    return v;
}
__device__ __forceinline__ float sigmoidf_(float x) { return __builtin_amdgcn_rcpf(1.0f + __expf(-x)); }
__device__ __forceinline__ float siluf_(float x) { return x * sigmoidf_(x); }

typedef const f32x4 (&AccRef)[2][2][4][2];

template <int BJ0, int BJ1, bool SSQ, bool RSC>
__device__ __forceinline__ void epi_store(AccRef acc, int row0, bf16_t* dst, int ld, int col0, float scale, float* ssq, const float* rss, float invk, int fq) {
#pragma unroll
    for (int ai = 0; ai < 2; ++ai)
#pragma unroll
        for (int m = 0; m < 4; ++m) {
            const int r = row0 + 128 * ai + 16 * m; float s = 0.f, sc = scale;
            if (RSC) sc *= __builtin_amdgcn_rsqf(rss[r] * invk + EPS);
#pragma unroll
            for (int bj = BJ0; bj < BJ1; ++bj) { const f32x4 v0 = acc[ai][bj][m][0], v1 = acc[ai][bj][m][1];
                if (SSQ) s += ((v0[0] * v0[0] + v0[1] * v0[1]) + (v0[2] * v0[2] + v0[3] * v0[3])) + ((v1[0] * v1[0] + v1[1] * v1[1]) + (v1[2] * v1[2] + v1[3] * v1[3]));
                st_pair16(dst + (size_t)r * ld + col0 + (bj - BJ0) * 128, pack4(v0 * sc), pack4(v1 * sc), fq); }
            if (SSQ) { s += __shfl_xor(s, 16); s += __shfl_xor(s, 32); if (fq == 0) atomicAdd(ssq + r, s); }
        }
}

struct EpiProj {
    static constexpr bool PERM = false, AFTER_DRAIN = false;
    bf16_t *CQ, *CKV, *KR, *FQ, *FK, *GM, *GF; float *LF, *SSQ, *SSK; const float *CS, *bforget;
    __device__ __forceinline__ void operator()(AccRef acc, const Unit& u, int wr, int wc, int fr_, int fq_) const {
        int ln_ = threadIdx.x & 63; asm volatile("" : "+v"(ln_)); const int fr = ln_ & 15, fq = ln_ >> 4; (void)fr_; (void)fq_;
        const int pn = u.pn, row0 = u.pm * 256 + wr * 64 + fr, cw = wc * 32 + 4 * fq;
        if (pn == 0) { epi_store<0, 2, true, false>(acc, row0, CQ, QR, cw, 1.f, SSQ, nullptr, 0.f, fq); }
        else if (pn == 1) {
            epi_store<0, 1, true, false>(acc, row0, CQ, QR, 256 + cw, 1.f, SSQ, nullptr, 0.f, fq);
            if (wc == 0) {
#pragma unroll
                for (int ai = 0; ai < 2; ++ai)
#pragma unroll
                    for (int m = 0; m < 4; ++m) { const int r = row0 + 128 * ai + 16 * m;
                        const f32x4 c = *(const f32x4*)(CS + (size_t)r * 16 + 4 * fq), s = *(const f32x4*)(CS + (size_t)T * 16 + (size_t)r * 16 + 4 * fq);
                        const f32x4 x1 = acc[ai][1][m][0], x2 = acc[ai][1][m][1];
                        st_pair16(KR + (size_t)r * 32 + 4 * fq, pack4(x1 * c - x2 * s), pack4(x2 * c + x1 * s), fq); }
            } else if (wc == 1) {
                if (fq < 2) {
                    const f32x4 bfg = *(const f32x4*)(bforget + 4 * fq);
#pragma unroll
                    for (int ai = 0; ai < 2; ++ai)
#pragma unroll
                        for (int m = 0; m < 4; ++m) { const int r = row0 + 128 * ai + 16 * m; const f32x4 z = acc[ai][1][m][0] + bfg; f32x4 o;
#pragma unroll
                            for (int j = 0; j < 4; ++j) o[j] = fminf(z[j], 0.f) - log1pf(expf(-fabsf(z[j])));
                            *(f32x4*)(LF + (size_t)r * 8 + 4 * fq) = o; }
                }
            }
        }
        else if (pn == 2) { epi_store<0, 2, true, false>(acc, row0, CKV, KVR, cw, 1.f, SSK, nullptr, 0.f, fq); }
        else if (pn <= 4) { epi_store<0, 2, false, false>(acc, row0, FQ, 512, (pn - 3) * 256 + cw, FOX_C, nullptr, nullptr, 0.f, fq); }
        else if (pn <= 6) { epi_store<0, 2, false, false>(acc, row0, FK, 512, (pn - 5) * 256 + cw, 1.f, nullptr, nullptr, 0.f, fq); }
        else {
            bf16_t* G = pn <= 10 ? GM : GF; const int cb = ((pn - 7) & 3) * 256 + cw;
#pragma unroll
            for (int ai = 0; ai < 2; ++ai)
#pragma unroll
                for (int m = 0; m < 4; ++m) { const int r = row0 + 128 * ai + 16 * m;
#pragma unroll
                    for (int bj = 0; bj < 2; ++bj) { f32x4 o[2];
#pragma unroll
                        for (int n = 0; n < 2; ++n) { const f32x4 v = acc[ai][bj][m][n];
#pragma unroll
                            for (int j = 0; j < 4; ++j) o[n][j] = fmaxf(sigmoidf_(v[j]), 8.6736174e-19f); }
                        st_pair16(G + (size_t)r * D + cb + bj * 128, pack4(o[0]), pack4(o[1]), fq); } }
        }
    }
};

struct EpiVt {
    static constexpr bool PERM = false, AFTER_DRAIN = false;
    bf16_t* dst; const float* ss; float invk;
    __device__ __forceinline__ void operator()(AccRef acc, const Unit& u, int wr, int wc, int fr_, int fq_) const {
        int ln_ = threadIdx.x & 63; asm volatile("" : "+v"(ln_)); const int fr = ln_ & 15, fq = ln_ >> 4; (void)fr_; (void)fq_;
        const int row0 = u.pm * 256 + wr * 64 + fr, c0 = u.pn * 256 + wc * 32 + 4 * fq;
        f32x4 sc[2][2];
#pragma unroll
        for (int bj = 0; bj < 2; ++bj)
#pragma unroll
            for (int n = 0; n < 2; ++n) { sc[bj][n] = (f32x4){1.f, 1.f, 1.f, 1.f};
                if (ss) { const f32x4 q = *(const f32x4*)(ss + c0 + bj * 128 + 16 * n);
#pragma unroll
                    for (int j = 0; j < 4; ++j) sc[bj][n][j] = __builtin_amdgcn_rsqf(q[j] * invk + EPS); } }
#pragma unroll
        for (int ai = 0; ai < 2; ++ai)
#pragma unroll
            for (int m = 0; m < 4; ++m) { const int r = row0 + 128 * ai + 16 * m;
#pragma unroll
                for (int bj = 0; bj < 2; ++bj)
                    st_pair16(dst + (size_t)r * T + c0 + bj * 128, pack4(acc[ai][bj][m][0] * sc[bj][0]), pack4(acc[ai][bj][m][1] * sc[bj][1]), fq); }
    }
};

struct EpiQ {
    static constexpr bool PERM = false, AFTER_DRAIN = false;
    bf16_t* Q; const float *SSQ, *CS;
    __device__ __forceinline__ void operator()(AccRef acc, const Unit& u, int wr, int wc, int fr_, int fq_) const {
        int ln_ = threadIdx.x & 63; asm volatile("" : "+v"(ln_)); const int fr = ln_ & 15, fq = ln_ >> 4; (void)fr_; (void)fq_;
        const int row0 = u.pm * 256 + wr * 64 + fr;
        const bool rope0 = ((8 * u.pn + wc) % 3) == 2, rope1 = ((8 * u.pn + 4 + wc) % 3) == 2;
        float ssv[8];
#pragma unroll
        for (int t = 0; t < 8; ++t) ssv[t] = SSQ[row0 + 128 * (t >> 2) + 16 * (t & 3)];
#pragma unroll
        for (int ai = 0; ai < 2; ++ai)
#pragma unroll
            for (int m = 0; m < 4; ++m) { const int r = row0 + 128 * ai + 16 * m;
                const float rs = __builtin_amdgcn_rsqf(ssv[4 * ai + m] * (1.0f / QR) + EPS) * MLA_C;
                f32x4 c = (f32x4){0.f, 0.f, 0.f, 0.f}, s = c;
                if (rope0 || rope1) { c = *(const f32x4*)(CS + (size_t)r * 16 + 4 * fq); s = *(const f32x4*)(CS + (size_t)T * 16 + (size_t)r * 16 + 4 * fq); }
#pragma unroll
                for (int bj = 0; bj < 2; ++bj) { const bool isrope = bj ? rope1 : rope0;
                    f32x4 v0 = acc[ai][bj][m][0] * rs, v1 = acc[ai][bj][m][1] * rs;
                    if (isrope) { const f32x4 o0 = v0 * c - v1 * s, o1 = v1 * c + v0 * s; v0 = o0; v1 = o1; }
                    st_pair16(Q + (size_t)r * 768 + u.pn * 256 + bj * 128 + wc * 32 + 4 * fq, pack4(v0), pack4(v1), fq); }
                asm volatile("" ::: "memory"); }
    }
};

struct EpiKN {
    static constexpr bool PERM = false, AFTER_DRAIN = false;
    bf16_t* KN; const float* SSK;
    __device__ __forceinline__ void operator()(AccRef acc, const Unit& u, int wr, int wc, int fr_, int fq_) const {
        int ln_ = threadIdx.x & 63; asm volatile("" : "+v"(ln_)); const int fr = ln_ & 15, fq = ln_ >> 4; (void)fr_; (void)fq_;
        epi_store<0, 2, false, true>(acc, u.pm * 256 + wr * 64 + fr, KN, 512, u.pn * 256 + wc * 32 + 4 * fq, 1.f, nullptr, SSK, 1.0f / KVR, fq);
    }
};

template <bool SECOND> struct EpiGate {
    static constexpr bool PERM = false, AFTER_DRAIN = false;
    const bf16_t* G; const bf16_t* T1; bf16_t* O;
    __device__ __forceinline__ void operator()(AccRef acc, const Unit& u, int wr, int wc, int fr_, int fq_) const {
        int ln_ = threadIdx.x & 63; asm volatile("" : "+v"(ln_)); const int fr = ln_ & 15, fq = ln_ >> 4; (void)fr_; (void)fq_;
        const int row0 = u.pm * 256 + wr * 64 + fr, c0 = u.pn * 256 + wc * 32 + 4 * fq;
#pragma unroll
        for (int ai = 0; ai < 2; ++ai)
#pragma unroll
            for (int m = 0; m < 4; ++m) { const size_t ro = (size_t)(row0 + 128 * ai + 16 * m) * D + c0;
#pragma unroll
                for (int bj = 0; bj < 2; ++bj)
#pragma unroll
                    for (int n = 0; n < 2; ++n) { const size_t o = ro + bj * 128 + 16 * n; const u32x2 g = *(const u32x2*)(G + o);
                        f32x4 v = acc[ai][bj][m][n] * (f32x4){bflo(g.x), bfhi(g.x), bflo(g.y), bfhi(g.y)};
                        if (SECOND) { const u32x2 t = *(const u32x2*)(T1 + o); v += (f32x4){bflo(t.x), bfhi(t.x), bflo(t.y), bfhi(t.y)}; }
                        *(u32x2*)(O + o) = pack4(v); } }
    }
};

constexpr int PAIR_DPM = (int)(((long long)WS_OF - (long long)WS_OM) / (256 * 512 * 2)), PAIR_DPN = (int)((WS_WOF - WS_WOM) / (256 * 512 * 2));
static_assert((long long)PAIR_DPM * (256 * 512 * 2) == (long long)WS_OF - (long long)WS_OM && (size_t)PAIR_DPN * (256 * 512 * 2) == WS_WOF - WS_WOM, "pair offsets are whole tiles");
struct PairOrder {
    pg8::StaticOrder S0;
    __device__ bool next(int i, Unit& u) const { if (!S0.next(i >> 1, u)) return false; if (i & 1) { u.pm += PAIR_DPM; u.pn += PAIR_DPN; } return true; }
    __device__ __forceinline__ void a_ready(const Unit&) const {}
    __device__ __forceinline__ void done(const Unit&) const {}
};
struct EpiGate2 {
    static constexpr bool PERM = false, AFTER_DRAIN = false, KEEP = true;
    const bf16_t *GMp, *GFp; bf16_t* Yp;
    __device__ __forceinline__ bool keep_acc(const Unit& u) const { return u.pn < 4; }
    __device__ __forceinline__ void operator()(f32x4 (&acc)[2][2][4][2], const Unit& u, int wr, int wc, int fr_, int fq_) const {
        int ln_ = threadIdx.x & 63; asm volatile("" : "+v"(ln_)); const int fr = ln_ & 15, fq = ln_ >> 4; (void)fr_; (void)fq_;
        const bool first = u.pn < 4; const int pm = first ? u.pm : u.pm - PAIR_DPM, pn = first ? u.pn : u.pn - PAIR_DPN;
        const int row0 = pm * 256 + wr * 64 + fr, c0 = pn * 256 + wc * 32 + 4 * fq;
#pragma unroll
        for (int ai = 0; ai < 2; ++ai)
#pragma unroll
            for (int m = 0; m < 4; ++m) { const size_t ro = (size_t)(row0 + 128 * ai + 16 * m) * D + c0;
#pragma unroll
                for (int bj = 0; bj < 2; ++bj) { u32x2 yw[2], gfw[2], gmw[2]; ld_pair16(GFp + ro + bj * 128, fq, gfw[0], gfw[1]);
                    if (first) ld_pair16(GMp + ro + bj * 128, fq, gmw[0], gmw[1]); else { gmw[0] = (u32x2){0u, 0u}; gmw[1] = gmw[0]; }
#pragma unroll
                    for (int n = 0; n < 2; ++n) { const u32x2 gf = gfw[n];
                        const f32x4 s2 = (f32x4){bflo(gf.x), bfhi(gf.x), bflo(gf.y), bfhi(gf.y)};
                        if (first) { const u32x2 gm = gmw[n]; f32x4 rt;
#pragma unroll
                            for (int j = 0; j < 4; ++j) rt[j] = __builtin_amdgcn_rcpf(s2[j]);
                            acc[ai][bj][m][n] = acc[ai][bj][m][n] * ((f32x4){bflo(gm.x), bfhi(gm.x), bflo(gm.y), bfhi(gm.y)} * rt); yw[n] = (u32x2){0u, 0u}; }
                        else yw[n] = pack4(acc[ai][bj][m][n] * s2); }
                    if (!first) st_pair16(Yp + ro + bj * 128, yw[0], yw[1], fq); }
                asm volatile("" ::: "memory"); }
    }
};

struct EpiRes {
    static constexpr bool PERM = false, AFTER_DRAIN = false;
    const float* base; float* out; const float* gate;
    __device__ __forceinline__ void operator()(AccRef acc, const Unit& u, int wr, int wc, int fr_, int fq_) const {
        int ln_ = threadIdx.x & 63; asm volatile("" : "+v"(ln_)); const int fr = ln_ & 15, fq = ln_ >> 4; (void)fr_; (void)fq_;
        const int row0 = u.pm * 256 + wr * 64 + fr, c0 = u.pn * 256 + wc * 32 + 4 * fq; const float* gp = gate + (u.pm >> 5) * 6144 + c0;
        f32x4 gv[2][2];
#pragma unroll
        for (int bj = 0; bj < 2; ++bj)
#pragma unroll
            for (int n = 0; n < 2; ++n) gv[bj][n] = *(const f32x4*)(gp + bj * 128 + 16 * n);
#pragma unroll
        for (int ai = 0; ai < 2; ++ai)
#pragma unroll
            for (int m = 0; m < 4; ++m) { const size_t ro = (size_t)(row0 + 128 * ai + 16 * m) * D + c0;
#pragma unroll
                for (int bj = 0; bj < 2; ++bj)
#pragma unroll
                    for (int n = 0; n < 2; ++n) { const size_t o = ro + bj * 128 + 16 * n; const f32x4 b = *(const f32x4*)(base + o);
                        *(f32x4*)(out + o) = b + gv[bj][n] * acc[ai][bj][m][n]; }
                asm volatile("" ::: "memory"); }
    }
};

template <bool FINAL> struct EpiResNorm {
    static constexpr bool PERM = false, AFTER_DRAIN = true;
    const float* base; float* out; const float* gate; float* ss; unsigned* cnt; const float* g; const float* sc; const float* sh; bf16_t* H;
    __device__ __forceinline__ void fused(f32x4 (&acc)[2][2][4][2], const Unit& u, int wr, int wc, int fr_, int fq_, LAS unsigned char* lds, int wid, int lane_) const {
        int ln_ = threadIdx.x & 63; asm volatile("" : "+v"(ln_)); const int fr = ln_ & 15, fq = ln_ >> 4; (void)fr_; (void)fq_; (void)lds; (void)wid; (void)lane_;
        const int row0 = u.pm * 256 + wr * 64 + fr, c0 = u.pn * 256 + wc * 32 + 4 * fq, b = u.pm >> 5; const float* gp = gate + b * 6144 + c0;
        {   f32x4 gv[2][2];
#pragma unroll
            for (int bj = 0; bj < 2; ++bj)
#pragma unroll
                for (int n = 0; n < 2; ++n) gv[bj][n] = *(const f32x4*)(gp + bj * 128 + 16 * n);
#pragma unroll
            for (int ai = 0; ai < 2; ++ai)
#pragma unroll
                for (int m = 0; m < 4; ++m) { const int r = row0 + 128 * ai + 16 * m; const size_t ro = (size_t)r * D + c0; float s = 0.f;
#pragma unroll
                    for (int bj = 0; bj < 2; ++bj)
#pragma unroll
                        for (int n = 0; n < 2; ++n) { const size_t o = ro + bj * 128 + 16 * n; const f32x4 xn = *(const f32x4*)(base + o) + gv[bj][n] * acc[ai][bj][m][n];
                            acc[ai][bj][m][n] = xn; s += (xn[0] * xn[0] + xn[1] * xn[1]) + (xn[2] * xn[2] + xn[3] * xn[3]); }
                    s += __shfl_xor(s, 16); s += __shfl_xor(s, 32); if (fq == 0) atomicAdd(ss + r, s);
                    asm volatile("" ::: "memory"); } }
        asm volatile("s_waitcnt vmcnt(0)" ::: "memory");
        __syncthreads();
        if (threadIdx.x == 0) {
            unsigned* cw = cnt + 64 * u.pm;
            __hip_atomic_fetch_add(cw, 1u, __ATOMIC_RELAXED, __HIP_MEMORY_SCOPE_AGENT);
        }
        if (!FINAL) {
#pragma unroll
            for (int ai = 0; ai < 2; ++ai)
#pragma unroll
                for (int m = 0; m < 4; ++m) { const size_t ro = (size_t)(row0 + 128 * ai + 16 * m) * D + c0;
#pragma unroll
                    for (int bj = 0; bj < 2; ++bj)
#pragma unroll
                        for (int n = 0; n < 2; ++n) *(f32x4*)(out + ro + bj * 128 + 16 * n) = acc[ai][bj][m][n]; }
        }
        if (threadIdx.x == 0) {
            unsigned* cw = cnt + 64 * u.pm;
            unsigned sp = 0;
            while (__hip_atomic_load(cw, __ATOMIC_RELAXED, __HIP_MEMORY_SCOPE_AGENT) < 4u) { __builtin_amdgcn_s_sleep(1); if (++sp > (1u << 22)) break; }
        }
        __syncthreads();
        f32x4 cA[2][2], cB[2][2];
#pragma unroll
        for (int bj = 0; bj < 2; ++bj)
#pragma unroll
            for (int n = 0; n < 2; ++n) { const int c = c0 + bj * 128 + 16 * n; cA[bj][n] = *(const f32x4*)(g + c);
                if (!FINAL) { cA[bj][n] = cA[bj][n] * (*(const f32x4*)(sc + b * 6144 + c) + 1.0f); cB[bj][n] = *(const f32x4*)(sh + b * 6144 + c); } else cB[bj][n] = (f32x4){0.f, 0.f, 0.f, 0.f}; }
#pragma unroll
        for (int ai = 0; ai < 2; ++ai)
#pragma unroll
            for (int m = 0; m < 4; ++m) { const int r = row0 + 128 * ai + 16 * m; const size_t ro = (size_t)r * D + c0;
                const float rstd = __builtin_amdgcn_rsqf(__hip_atomic_load(ss + r, __ATOMIC_RELAXED, __HIP_MEMORY_SCOPE_AGENT) * (1.0f / D) + EPS);
#pragma unroll
                for (int bj = 0; bj < 2; ++bj) { u32x2 hw[2];
#pragma unroll
                    for (int n = 0; n < 2; ++n) { const size_t o = ro + bj * 128 + 16 * n; const f32x4 y = acc[ai][bj][m][n] * rstd * cA[bj][n];
                        if (FINAL) { *(f32x4*)(out + o) = y; hw[n] = (u32x2){0u, 0u}; }
                        else hw[n] = pack4(y + cB[bj][n]); }
                    if (!FINAL) st_pair16(H + ro + bj * 128, hw[0], hw[1], fq); }
                asm volatile("" ::: "memory"); }
    }
};

__device__ __forceinline__ f32x4 shfl4(f32x4 v, int src) { f32x4 o;
#pragma unroll
    for (int j = 0; j < 4; ++j) o[j] = __shfl(v[j], src);
    return o; }
struct EpiConv {
    static constexpr bool PERM = false, AFTER_DRAIN = false;
    bf16_t* ACT; float *HALO, *PART; const float *cw, *cb;
    __device__ __forceinline__ void operator()(AccRef acc, const Unit& u, int wr, int wc, int fr_, int fq_) const {
        int ln_ = threadIdx.x & 63; asm volatile("" : "+v"(ln_)); const int fr = ln_ & 15, fq = ln_ >> 4; (void)fr_; (void)fq_;
        const int lane = fq * 16 + fr, s1 = fq * 16 + ((fr + 15) & 15), s2 = fq * 16 + ((fr + 14) & 15);
#pragma unroll
        for (int ai = 0; ai < 2; ++ai) { const int grp = 4 * u.pm + 2 * ai + wr, r0 = 64 * grp + fr; u32x2 aw0[4];
#pragma unroll
            for (int n = 0; n < 2; ++n) { const int ng = 128 * u.pn + 32 * wc + 16 * n + 4 * fq;
                const f32x4 wg0 = *(const f32x4*)(cw + ng), wg1 = *(const f32x4*)(cw + NUP + ng), wg2 = *(const f32x4*)(cw + 2 * NUP + ng), bg = *(const f32x4*)(cb + ng);
                const f32x4 wv0 = *(const f32x4*)(cw + DFF + ng), wv1 = *(const f32x4*)(cw + NUP + DFF + ng), wv2 = *(const f32x4*)(cw + 2 * NUP + DFF + ng), bv = *(const f32x4*)(cb + DFF + ng);
                f32x4 pg1 = (f32x4){0.f, 0.f, 0.f, 0.f}, pg2 = pg1, pv1 = pg1, pv2 = pg1;
#pragma unroll
                for (int m = 0; m < 4; ++m) { const f32x4 G = acc[ai][0][m][n], V = acc[ai][1][m][n];
                    const f32x4 g1 = shfl4(G, s1), g2 = shfl4(G, s2), v1 = shfl4(V, s1), v2 = shfl4(V, s2);
                    const f32x4 gm1 = fr >= 1 ? g1 : pg1, gm2 = fr >= 2 ? g2 : pg2, vm1 = fr >= 1 ? v1 : pv1, vm2 = fr >= 2 ? v2 : pv2;
                    const f32x4 cg = bg + wg0 * gm2 + wg1 * gm1 + wg2 * G, cv = bv + wv0 * vm2 + wv1 * vm1 + wv2 * V;
                    const int r = r0 + 16 * m;
                    if (m == 0 && fr < 2) { *(f32x4*)(PART + ((size_t)grp * 2 + fr) * NUP + ng) = cg; *(f32x4*)(PART + ((size_t)grp * 2 + fr) * NUP + DFF + ng) = cv; }
                    { f32x4 a;
#pragma unroll
                        for (int j = 0; j < 4; ++j) a[j] = siluf_(cg[j]) * cv[j];
                        if (n == 0) { aw0[m] = pack4(a); asm volatile("" : "+v"(aw0[m].x), "+v"(aw0[m].y)); }
                        else st_pair16_if(ACT + (size_t)r * DFF + ng - 16, aw0[m], pack4(a), fq, !(m == 0 && fr < 2)); }
                    if (m == 3 && fr >= 14) { *(f32x4*)(HALO + ((size_t)grp * 2 + (fr - 14)) * NUP + ng) = G; *(f32x4*)(HALO + ((size_t)grp * 2 + (fr - 14)) * NUP + DFF + ng) = V; }
                    pg1 = g1; pg2 = g2; pv1 = v1; pv2 = v2;
                    asm volatile("" ::: "memory"); }
                (void)lane; } }
    }
};

__device__ __forceinline__ int crow(int r, int hi) { return (r & 3) + 8 * (r >> 2) + 4 * hi; }
constexpr int VSTR = 264, ATT_VOFF = 2 * 128 * 208;
template <int NCH> struct AttLoader { const bf16_t* ksrc[3]; size_t kstp[3]; int kdst[3]; bool kact[3]; const bf16_t* vsrc[2]; int vdst[2]; };
template <int NCH> __device__ __forceinline__ void att_load(const AttLoader<NCH>& L, int it, u32x4 (&kr)[3], u32x4 (&vr)[2]) {
#pragma unroll
    for (int i = 0; i < 3; ++i) if (L.kact[i]) kr[i] = *(const u32x4*)(L.ksrc[i] + (size_t)it * L.kstp[i]);
#pragma unroll
    for (int i = 0; i < 2; ++i) vr[i] = *(const u32x4*)(L.vsrc[i] + (size_t)it * 128);
}
template <int NCH, int KSTR> __device__ __forceinline__ void att_write(LAS unsigned char* lds, const AttLoader<NCH>& L, int buf, const u32x4 (&kr)[3], const u32x4 (&vr)[2]) {
#pragma unroll
    for (int i = 0; i < 3; ++i) if (L.kact[i]) *(LAS u32x4*)(lds + buf * (128 * KSTR) + L.kdst[i]) = kr[i];
#pragma unroll
    for (int i = 0; i < 2; ++i) { *(LAS u32x2*)(lds + L.vdst[i] + buf * (64 * VSTR)) = (u32x2){vr[i].x, vr[i].y}; *(LAS u32x2*)(lds + L.vdst[i] + buf * (64 * VSTR) + 8) = (u32x2){vr[i].z, vr[i].w}; }
}
struct AttState { f32x16 o0, o1, negm; float mref, lrun; };
template <int NSTEP, int KSTR> __device__ __forceinline__ void att_compute(LAS unsigned char* lds, int it, int buf, bool first, int wq0, int qrow, int r32, int hi, const bf16x8 (&qf)[NSTEP], AttState& S) {
    const LAS unsigned char* kbuf = lds + buf * (128 * KSTR);
#pragma unroll
    for (int s = 0; s < 2; ++s) { if ((128 * it + 64 * s) <= wq0 + 31) {
        f32x16 p[2];
        {
            bf16x8 kf[2][NSTEP];
#pragma unroll
            for (int hh = 0; hh < 2; ++hh)
#pragma unroll
                for (int d0 = 0; d0 < NSTEP; ++d0) kf[hh][d0] = *(const LAS bf16x8*)(kbuf + (64 * s + 32 * hh + r32) * KSTR + d0 * 32 + hi * 16);
            __builtin_amdgcn_sched_barrier(0);
            if (NSTEP == 5) { if (hi) { kf[0][4] = (bf16x8){0, 0, 0, 0, 0, 0, 0, 0}; kf[1][4] = (bf16x8){0, 0, 0, 0, 0, 0, 0, 0}; } }
            f32x16 a0 = S.negm, a1 = S.negm;
#pragma unroll
            for (int d0 = 0; d0 < NSTEP; ++d0) { a0 = __builtin_amdgcn_mfma_f32_32x32x16_bf16(kf[0][d0], qf[d0], a0, 0, 0, 0); a1 = __builtin_amdgcn_mfma_f32_32x32x16_bf16(kf[1][d0], qf[d0], a1, 0, 0, 0); }
            p[0] = a0; p[1] = a1; }
        const int kv0 = 128 * it + 64 * s;
        if (kv0 + 63 > wq0) {
#pragma unroll
            for (int hh = 0; hh < 2; ++hh)
#pragma unroll
                for (int r = 0; r < 16; ++r) { const int kvg = kv0 + 32 * hh + crow(r, hi); if (kvg > qrow) p[hh][r] = -INFINITY; }
        }
        float mx = fmaxf(fmaxf(p[0][0], p[1][0]), fmaxf(p[0][1], p[1][1]));
#pragma unroll
        for (int r = 2; r < 16; r += 2) mx = fmaxf(fmaxf(mx, p[0][r]), fmaxf(fmaxf(p[1][r], p[0][r + 1]), p[1][r + 1]));
        mx = fmaxf(mx, __shfl_xor(mx, 32));
        if ((first && s == 0) || __any(mx > 24.0f)) {
            const float delta = (first && s == 0) ? mx : fmaxf(mx, 0.f), sc = __builtin_amdgcn_exp2f(-delta);
            S.mref += delta; S.lrun *= sc;
#pragma unroll
            for (int r = 0; r < 16; ++r) { S.o0[r] *= sc; S.o1[r] *= sc; p[0][r] -= delta; p[1][r] -= delta; S.negm[r] = -S.mref; }
        }
        const LAS unsigned char* vb = lds + ATT_VOFF + buf * (64 * VSTR) + r32 * VSTR + s * 128 + hi * 8;
        u32x2 vf[2][4][2];
#pragma unroll
        for (int db = 0; db < 2; ++db)
#pragma unroll
            for (int j = 0; j < 4; ++j) { vf[db][j][0] = *(const LAS u32x2*)(vb + db * 32 * VSTR + j * 32); vf[db][j][1] = *(const LAS u32x2*)(vb + db * 32 * VSTR + j * 32 + 16); }
        __builtin_amdgcn_sched_barrier(0);
        float rs0 = 0.f, rs1 = 0.f;
#pragma unroll
        for (int r = 0; r < 16; ++r) { const float e0 = __builtin_amdgcn_exp2f(p[0][r]), e1 = __builtin_amdgcn_exp2f(p[1][r]); p[0][r] = e0; p[1][r] = e1; rs0 += e0; rs1 += e1; }
        S.lrun += rs0 + rs1;
        bf16x8 pb[4];
#pragma unroll
        for (int j = 0; j < 4; ++j) { const int hh = j >> 1, rb = 8 * (j & 1);
            const unsigned w0 = cvt_pk_bf16(p[hh][rb + 0], p[hh][rb + 1]), w1 = cvt_pk_bf16(p[hh][rb + 2], p[hh][rb + 3]), w2 = cvt_pk_bf16(p[hh][rb + 4], p[hh][rb + 5]), w3 = cvt_pk_bf16(p[hh][rb + 6], p[hh][rb + 7]);
            pb[j] = __builtin_bit_cast(bf16x8, (u32x4){w0, w1, w2, w3}); }
#pragma unroll
        for (int j = 0; j < 4; ++j) {
            S.o0 = __builtin_amdgcn_mfma_f32_32x32x16_bf16(__builtin_bit_cast(bf16x8, (u32x4){vf[0][j][0].x, vf[0][j][0].y, vf[0][j][1].x, vf[0][j][1].y}), pb[j], S.o0, 0, 0, 0);
            S.o1 = __builtin_amdgcn_mfma_f32_32x32x16_bf16(__builtin_bit_cast(bf16x8, (u32x4){vf[1][j][0].x, vf[1][j][0].y, vf[1][j][1].x, vf[1][j][1].y}), pb[j], S.o1, 0, 0, 0); }
    } }
}
template <int NSTEP, int NCH, int KSTR>
__device__ __forceinline__ void attn_unit(LAS unsigned char* lds, int b, int h, int qb, const bf16_t* Qp, int qld, int qcol,
                                          const bf16_t* K1, int k1ld, int k1col, const bf16_t* K2, int k2ld, int k2col, const bf16_t* Vt, int vrow0, bf16_t* O, int ocol, int it0) {
    int tid_ = threadIdx.x; asm volatile("" : "+v"(tid_));
    const int tid = tid_, lane = tid & 63, r32 = lane & 31, hi = lane >> 5, wid = __builtin_amdgcn_readfirstlane(tid >> 6);
    const size_t rowbase = (size_t)b * SEQ;
    const int qrow = 256 * qb + 32 * wid + r32;
    bf16x8 qf[NSTEP];
#pragma unroll
    for (int d0 = 0; d0 < (NSTEP == 6 ? 6 : 4); ++d0) qf[d0] = *(const bf16x8*)(Qp + (rowbase + qrow) * qld + qcol + 16 * d0 + 8 * hi);
    if (NSTEP == 5) { const short one = hi ? (short)0 : (short)0x3F80; qf[NSTEP - 1] = (bf16x8){one, one, one, 0, 0, 0, 0, 0}; }
    AttLoader<NCH> L;
#pragma unroll
    for (int i = 0; i < 3; ++i) { const int idx = tid + 512 * i; L.kact[i] = idx < 128 * NCH; const int row = idx / NCH, c = idx % NCH;
        L.ksrc[i] = c < 8 ? K1 + (rowbase + row) * k1ld + k1col + 8 * c : K2 + (rowbase + row) * k2ld + k2col + 8 * (c - 8);
        L.kstp[i] = (size_t)128 * (c < 8 ? k1ld : k2ld); L.kdst[i] = row * KSTR + c * 16; }
#pragma unroll
    for (int i = 0; i < 2; ++i) { const int idx = tid + 512 * i, d = idx >> 4, c = idx & 15; L.vsrc[i] = Vt + (size_t)(vrow0 + d) * T + rowbase + 8 * c; L.vdst[i] = ATT_VOFF + d * VSTR + c * 16; }
    const int NIT = 2 * qb + 2;
    u32x4 kA[3], vA[2], kB[3], vB[2];
    att_load<NCH>(L, it0, kA, vA); att_write<NCH, KSTR>(lds, L, 0, kA, vA);
    att_load<NCH>(L, it0 + 1, kB, vB);
    __syncthreads();
    AttState S; S.o0 = f32x16{}; S.o1 = f32x16{}; S.negm = f32x16{}; S.mref = 0.f; S.lrun = 0.f;
    const int wq0 = 256 * qb + 32 * wid;
    for (int it = it0; it < NIT; it += 2) {
        if (it + 2 < NIT) att_load<NCH>(L, it + 2, kA, vA);
        att_compute<NSTEP, KSTR>(lds, it, 0, it == it0, wq0, qrow, r32, hi, qf, S);
        att_write<NCH, KSTR>(lds, L, 1, kB, vB);
        __syncthreads();
        if (it + 3 < NIT) att_load<NCH>(L, it + 3, kB, vB);
        att_compute<NSTEP, KSTR>(lds, it + 1, 1, false, wq0, qrow, r32, hi, qf, S);
        if (it + 2 < NIT) att_write<NCH, KSTR>(lds, L, 0, kA, vA);
        __syncthreads();
    }
    float lrun = S.lrun; lrun += __shfl_xor(lrun, 32);
    const float inv = 1.0f / lrun;
    bf16_t* op = O + (rowbase + qrow) * 512 + ocol + 8 * hi;
#pragma unroll
    for (int k = 0; k < 2; ++k) {
        const u32x2 a0 = pack4((f32x4){S.o0[8 * k], S.o0[8 * k + 1], S.o0[8 * k + 2], S.o0[8 * k + 3]} * inv), a1 = pack4((f32x4){S.o0[8 * k + 4], S.o0[8 * k + 5], S.o0[8 * k + 6], S.o0[8 * k + 7]} * inv);
        const u32x2 b0 = pack4((f32x4){S.o1[8 * k], S.o1[8 * k + 1], S.o1[8 * k + 2], S.o1[8 * k + 3]} * inv), b1 = pack4((f32x4){S.o1[8 * k + 4], S.o1[8 * k + 5], S.o1[8 * k + 6], S.o1[8 * k + 7]} * inv);
        const auto ax = __builtin_amdgcn_permlane32_swap(a0.x, a1.x, false, false), ay = __builtin_amdgcn_permlane32_swap(a0.y, a1.y, false, false);
        const auto bx = __builtin_amdgcn_permlane32_swap(b0.x, b1.x, false, false), by = __builtin_amdgcn_permlane32_swap(b0.y, b1.y, false, false);
        *(u32x4*)(op + 16 * k) = (u32x4){ax[0], ay[0], ax[1], ay[1]};
        *(u32x4*)(op + 32 + 16 * k) = (u32x4){bx[0], by[0], bx[1], by[1]}; }
}

#define XB_TMO      128
#define XB_XCNT(j)  (256  + 64 * (j))
#define XB_XSUB(j)  (1280 + 64 * (j))
#define XB_XGEN(j)  (2304 + 64 * (j))
#define XB_TOP      3328
#define XB_TOPGEN   3392
#define XCD_BAR_WORDS 3456
#define XB_SPIN_CAP (1u << 18)

__device__ __forceinline__ unsigned xb_ld(unsigned* p)              { return __hip_atomic_load(p, __ATOMIC_RELAXED, __HIP_MEMORY_SCOPE_AGENT); }
__device__ __forceinline__ unsigned xb_add(unsigned* p, unsigned v) { return __hip_atomic_fetch_add(p, v, __ATOMIC_RELAXED, __HIP_MEMORY_SCOPE_AGENT); }
__device__ __forceinline__ unsigned xb_xcc_id() { return (unsigned)__builtin_amdgcn_s_getreg((3 << 11) | 20) & 0xFu; }
#define XB_SPIN(cond, bar) do { unsigned _sp = 0; while (cond) { __builtin_amdgcn_s_sleep(1); \
    if ((++_sp & 255u) == 0u) { if (xb_ld(&(bar)[XB_TMO])) break; if (_sp > XB_SPIN_CAP) { atomicAdd(&(bar)[XB_TMO], 1u); break; } } } } while (0)

struct XcdBarrier {
    unsigned* bar; unsigned x;
    volatile LAS unsigned* st;
};

__device__ __forceinline__ XcdBarrier xcd_barrier_post(unsigned* bar, volatile LAS unsigned* st) {
    XcdBarrier b; b.bar = bar; b.x = xb_xcc_id(); b.st = st;
    if (threadIdx.x == 0) (void)xb_add(&bar[XB_XCNT(b.x)], 1u);
    return b;
}
__device__ __forceinline__ void xcd_barrier_complete(unsigned* bar, unsigned x, unsigned& nloc, unsigned& nx) {
    const unsigned G = gridDim.x * gridDim.y * gridDim.z;
    unsigned sum, cnt, mine, sp = 0u;
    for (;;) {
        sum = 0u; cnt = 0u; mine = 0u;
#pragma unroll
        for (unsigned j = 0; j < 16; ++j) { const unsigned c = xb_ld(&bar[XB_XCNT(j)]); sum += c; cnt += (c > 0u) ? 1u : 0u; mine = (j == x) ? c : mine; }
        if (sum == G) break;
        __builtin_amdgcn_s_sleep(1);
        if ((++sp & 255u) == 0u) { if (xb_ld(&bar[XB_TMO])) break; if (sp > XB_SPIN_CAP) { atomicAdd(&bar[XB_TMO], 1u); break; } }
    }
    nloc = mine > 0u ? mine : 1u; nx = cnt > 0u ? cnt : 1u;
}

__device__ __forceinline__ void xcd_barrier(const XcdBarrier& b) {
    asm volatile("s_waitcnt vmcnt(0)" ::: "memory");
    __syncthreads();
    if (threadIdx.x == 0) {
        unsigned* bar = b.bar;
        __builtin_amdgcn_s_waitcnt(0);
        unsigned nloc = b.st[0], nx = b.st[1];
        if (nloc == 0u) { xcd_barrier_complete(bar, b.x, nloc, nx); b.st[0] = nloc; b.st[1] = nx; }
        const unsigned old = xb_add(&bar[XB_XSUB(b.x)], 1u);
        const unsigned gen = old / nloc;
        if (old + 1u == (gen + 1u) * nloc) {
            __builtin_amdgcn_fence(__ATOMIC_RELEASE, "agent");
            asm volatile("s_waitcnt vmcnt(0)" ::: "memory");
            const unsigned og = xb_add(&bar[XB_TOP], 1u);
            const unsigned tg = og / nx;
            if (og + 1u == (tg + 1u) * nx) xb_add(&bar[XB_TOPGEN], 1u);
            else XB_SPIN(xb_ld(&bar[XB_TOPGEN]) == tg, bar);
            __builtin_amdgcn_fence(__ATOMIC_ACQUIRE, "agent");
            xb_add(&bar[XB_XGEN(b.x)], 1u);
            asm volatile("s_waitcnt vmcnt(0)" ::: "memory");
        } else {
            XB_SPIN(xb_ld(&bar[XB_XGEN(b.x)]) == gen, bar);
            __builtin_amdgcn_fence(__ATOMIC_ACQUIRE, "agent");
            asm volatile("s_waitcnt vmcnt(0)" ::: "memory");
        }
    }
    __syncthreads();
}

struct Args { const void* in[21]; float* out; unsigned char* ws; int ph_lo, ph_hi; };
constexpr int NPH = 12;

__device__ __forceinline__ void transpose_item(const float* W, int ldw, int k0, int sc0, int nvalid, const float* kscale, bf16_t* WT, int K, int drow0, LAS float* scr, int lane) {
    const int c4 = lane & 7, r8 = lane >> 3;
#pragma unroll
    for (int i = 0; i < 8; ++i) { const int kk = 8 * i + r8; f32x4 v = (f32x4){0.f, 0.f, 0.f, 0.f};
        if (4 * c4 < nvalid) { v = *(const f32x4*)(W + (size_t)(k0 + kk) * ldw + sc0 + 4 * c4); if (kscale) v = v * kscale[k0 + kk]; }
        LAS float* sp = scr + kk * 33 + 4 * c4; sp[0] = v[0]; sp[1] = v[1]; sp[2] = v[2]; sp[3] = v[3]; }
    asm volatile("s_waitcnt lgkmcnt(0)" ::: "memory");
    const int c = lane & 7;
#pragma unroll
    for (int j = 0; j < 4; ++j) { const int n = (lane >> 3) + 8 * j; const LAS float* s = scr + (8 * c) * 33 + n;
        u32x4 o; o.x = cvt_pk_bf16(s[0 * 33], s[1 * 33]); o.y = cvt_pk_bf16(s[2 * 33], s[3 * 33]); o.z = cvt_pk_bf16(s[4 * 33], s[5 * 33]); o.w = cvt_pk_bf16(s[6 * 33], s[7 * 33]);
        *(u32x4*)(WT + (size_t)(drow0 + n) * K + k0 + 8 * c) = o; }
    asm volatile("s_waitcnt lgkmcnt(0)" ::: "memory");
}
__device__ __forceinline__ void win_map(int d0, int& sc0, int& nv) {
    nv = 32;
    if (d0 < 384) sc0 = d0; else if (d0 < 416) sc0 = 640 + (d0 - 384); else if (d0 < 448) { sc0 = 2208; nv = 8; } else if (d0 < 512) { sc0 = 0; nv = 0; }
    else if (d0 < 768) sc0 = 384 + (d0 - 512); else if (d0 < 1280) sc0 = 672 + (d0 - 768); else if (d0 < 1792) sc0 = 1184 + (d0 - 1280);
    else if (d0 < 2816) sc0 = 2216 + (d0 - 1792); else if (d0 < 3840) sc0 = 3240 + (d0 - 2816); else sc0 = 1696 + (d0 - 3840);
}

template <int NR> __device__ __forceinline__ void modnorm_rows(const float* xrow, bf16_t* orow, const float* g, const float* sc, const float* sh, int lane, size_t rstride) {
    f32x4 v[NR][4]; float s[NR];
#pragma unroll
    for (int q = 0; q < NR; ++q)
#pragma unroll
        for (int j = 0; j < 4; ++j) v[q][j] = *((const f32x4*)(xrow + q * rstride) + lane + 64 * j);
#pragma unroll
    for (int q = 0; q < NR; ++q) { s[q] = 0.f;
#pragma unroll
        for (int j = 0; j < 4; ++j) s[q] += (v[q][j][0] * v[q][j][0] + v[q][j][1] * v[q][j][1]) + (v[q][j][2] * v[q][j][2] + v[q][j][3] * v[q][j][3]); }
#pragma unroll
    for (int q = 0; q < NR; ++q) { const float rstd = __builtin_amdgcn_rsqf(wave_sum(s[q]) * (1.0f / D) + EPS);
#pragma unroll
        for (int j = 0; j < 4; ++j) { const int c = 4 * (lane + 64 * j); const f32x4 gg = *(const f32x4*)(g + c), ss = *(const f32x4*)(sc + c), hh = *(const f32x4*)(sh + c);
            const f32x4 y = (v[q][j] * rstd * gg) * (ss + 1.0f) + hh; *(u32x2*)(orow + q * rstride + c) = pack4(y); } }
}
template <int NR> __device__ __forceinline__ void modnorm_rows_c(const float* xrow, bf16_t* orow, const f32x4 (&cA)[4], const f32x4 (&cB)[4], int lane, size_t rstride) {
    f32x4 v[NR][4]; float s[NR];
#pragma unroll
    for (int q = 0; q < NR; ++q)
#pragma unroll
        for (int j = 0; j < 4; ++j) v[q][j] = *((const f32x4*)(xrow + q * rstride) + lane + 64 * j);
#pragma unroll
    for (int q = 0; q < NR; ++q) { s[q] = 0.f;
#pragma unroll
        for (int j = 0; j < 4; ++j) s[q] += (v[q][j][0] * v[q][j][0] + v[q][j][1] * v[q][j][1]) + (v[q][j][2] * v[q][j][2] + v[q][j][3] * v[q][j][3]); }
#pragma unroll
    for (int q = 0; q < NR; ++q) { const float rstd = __builtin_amdgcn_rsqf(wave_sum(s[q]) * (1.0f / D) + EPS);
#pragma unroll
        for (int j = 0; j < 4; ++j) *(u32x2*)(orow + q * rstride + 4 * (lane + 64 * j)) = pack4(v[q][j] * rstd * cA[j] + cB[j]); }
}

template <unsigned MASK> __global__ void __launch_bounds__(NTHR, 2) mk_fwd(Args args) {
    extern __shared__ __attribute__((aligned(16))) unsigned char lds_raw[];
    LAS unsigned char* lds = (LAS unsigned char*)lds_raw;
    cg::grid_group grid = cg::this_grid();
    const int tid = threadIdx.x, lane = tid & 63, wave = __builtin_amdgcn_readfirstlane(tid >> 6);
    const int G = gridDim.x, bid = blockIdx.x;
    const int gw = bid * NWAVES + wave, NGW = G * NWAVES;
    unsigned char* ws = args.ws;
    const float* x = (const float*)args.in[0]; const float* cvec = (const float*)args.in[1]; const int* positions = (const int*)args.in[2];
    const float* w_ada = (const float*)args.in[3]; const float* b_ada = (const float*)args.in[4]; const float* norm_mix_g = (const float*)args.in[5];
    const float* w_in = (const float*)args.in[6]; const float* q_norm_g = (const float*)args.in[7]; const float* w_uq = (const float*)args.in[8];
    const float* kv_norm_g = (const float*)args.in[9]; const float* w_ukv = (const float*)args.in[10]; const float* b_forget = (const float*)args.in[11];
    const float* w_o_mla = (const float*)args.in[12]; const float* w_o_fox = (const float*)args.in[13]; const float* w_out = (const float*)args.in[14];
    const float* norm_ffn_g = (const float*)args.in[15]; const float* w_up = (const float*)args.in[16]; const float* conv_w = (const float*)args.in[17];
    const float* conv_b = (const float*)args.in[18]; const float* w_down = (const float*)args.in[19]; const float* norm_final_g = (const float*)args.in[20];
    float* out = args.out;
    bf16_t *Win_t = (bf16_t*)(ws + WS_WIN), *Wuq_t = (bf16_t*)(ws + WS_WUQ), *Wukv_t = (bf16_t*)(ws + WS_WUKV), *Wom_t = (bf16_t*)(ws + WS_WOM), *Wof_t = (bf16_t*)(ws + WS_WOF),
           *Wout_t = (bf16_t*)(ws + WS_WOUT), *Wup_t = (bf16_t*)(ws + WS_WUP), *Wdn_t = (bf16_t*)(ws + WS_WDN);
    bf16_t *HA = (bf16_t*)(ws + WS_HA), *CQ = (bf16_t*)(ws + WS_CQ), *CKV = (bf16_t*)(ws + WS_CKV), *KR = (bf16_t*)(ws + WS_KR), *FB = (bf16_t*)(ws + WS_FB),
           *FQ = (bf16_t*)(ws + WS_FQ), *FK = (bf16_t*)(ws + WS_FK), *FVt = (bf16_t*)(ws + WS_FVT), *GM = (bf16_t*)(ws + WS_GM), *GF = (bf16_t*)(ws + WS_GF),
           *KN = (bf16_t*)(ws + WS_KN), *VMt = (bf16_t*)(ws + WS_VMT), *OM = (bf16_t*)(ws + WS_OM), *OF = (bf16_t*)(ws + WS_OF), *Qb = (bf16_t*)(ws + WS_Q),
           *T1 = (bf16_t*)(ws + WS_T1), *H2 = (bf16_t*)(ws + WS_H2), *Y = (bf16_t*)(ws + WS_Y), *ACT = (bf16_t*)(ws + WS_ACT);
    float *ADA = (float*)(ws + WS_ADA), *SSQ = (float*)(ws + WS_SSQ), *SSK = (float*)(ws + WS_SSK), *CS = (float*)(ws + WS_CS), *LF = (float*)(ws + WS_LF),
          *HALO = (float*)(ws + WS_HALO), *PART = (float*)(ws + WS_PART), *NF = (float*)(ws + WS_NF), *NRM = (float*)(ws + WS_NRM);
    const int lo = args.ph_lo, hi = args.ph_hi & 0xff, sub = args.ph_hi >> 8;
    const bool fusednorm = (G == 256) && (hi - lo > 1);
#define IN(k) (((MASK >> (k)) & 1u) && lo <= (k) && (k) < hi)
    volatile LAS unsigned* bst = (volatile LAS unsigned*)(lds + 131072 + 64);
    XcdBarrier xbar; xbar.bar = (unsigned*)(ws + WS_BAR); xbar.x = 0; xbar.st = bst;
    if (hi - lo > 1) { if (tid == 0) { bst[0] = 0u; bst[1] = 0u; } __syncthreads(); xbar = xcd_barrier_post((unsigned*)(ws + WS_BAR), bst); }
#define SEAM(k) do { if (IN(k) && IN((k) + 1)) { if (args.ph_hi > 0xFFFF) grid.sync();   xcd_barrier(xbar); } } while (0)

    if (IN(0)) {
#pragma unroll 1
      for (int mprep = 0; mprep < MP_REPS; ++mprep) {
        LAS float* sl = (LAS float*)lds;
        for (int i = tid; i < 2 * D; i += NTHR) sl[i] = siluf_(cvec[i]);
        __syncthreads();
        for (int cgp = bid; cgp < 192; cgp += G) {
            const int c4 = lane & 7, ks = lane >> 3; f32x4 a0 = (f32x4){0.f, 0.f, 0.f, 0.f}, a1 = a0;
#pragma unroll
            for (int i = 0; i < 16; ++i) { const int k = 128 * wave + 8 * i + ks; const f32x4 w = *(const f32x4*)(w_ada + (size_t)k * 6144 + cgp * 32 + 4 * c4); a0 += w * sl[k]; a1 += w * sl[D + k]; }
#pragma unroll
            for (int j = 0; j < 4; ++j) { a0[j] += __shfl_xor(a0[j], 8); a0[j] += __shfl_xor(a0[j], 16); a0[j] += __shfl_xor(a0[j], 32); a1[j] += __shfl_xor(a1[j], 8); a1[j] += __shfl_xor(a1[j], 16); a1[j] += __shfl_xor(a1[j], 32); }
            if (lane < 8) {
#pragma unroll
                for (int j = 0; j < 4; ++j) { sl[2048 + (wave * 2 + 0) * 32 + 4 * lane + j] = a0[j]; sl[2048 + (wave * 2 + 1) * 32 + 4 * lane + j] = a1[j]; } }
            __syncthreads();
            if (tid < 64) { const int bb = tid >> 5, nn = tid & 31; float s = b_ada[cgp * 32 + nn];
#pragma unroll
                for (int w = 0; w < 8; ++w) s += sl[2048 + (w * 2 + bb) * 32 + nn];
                ADA[bb * 6144 + cgp * 32 + nn] = s; }
            __syncthreads();
        }
        __syncthreads();
        for (int i = bid * NTHR + tid; i < T * 16; i += G * NTHR) { const int row = i >> 4, k = i & 15;
            const double rev = (double)positions[row] * INVF[k] * 0.15915494309189535; const double fr = rev - floor(rev);
            const float a = (float)(fr < 0.5 ? fr : fr - 1.0) * 6.283185307179586f;
            CS[i] = __cosf(a); CS[T * 16 + i] = __sinf(a); }
        LAS float* scr = (LAS float*)(lds + 16384 + wave * 8704);
        constexpr int I_IN = (DINP / 32) * 16, I_UQ = 24 * 6, I_UKV = 32 * 4, I_OM = 32 * 8, I_OUT = 32 * 16, I_UP = (NUP / 32) * 16, I_DN = 32 * 44;
        constexpr int NITEMS = I_IN + I_UQ + I_UKV + 2 * I_OM + I_OUT + I_UP + I_DN;
        for (int it = gw; it < NITEMS; it += NGW) {
            int r = it;
            if (r < I_IN) { const int rb = r % (DINP / 32), kb = r / (DINP / 32); int sc0, nv; win_map(32 * rb, sc0, nv); transpose_item(w_in, DIN, 64 * kb, sc0, nv, nullptr, Win_t, D, 32 * rb, scr, lane); continue; } r -= I_IN;
            if (r < I_UQ) { const int rb = r % 24, kb = r / 24; transpose_item(w_uq, 768, 64 * kb, 32 * rb, 32, q_norm_g, Wuq_t, QR, 32 * rb, scr, lane); continue; } r -= I_UQ;
            if (r < I_UKV) { const int rb = r % 32, kb = r / 32; const int d0 = 32 * rb, dd = d0 & 511, sc0 = (dd >> 6) * 128 + (dd & 63) + (d0 >= 512 ? 64 : 0);
                transpose_item(w_ukv, 1024, 64 * kb, sc0, 32, kv_norm_g, Wukv_t, KVR, d0, scr, lane); continue; } r -= I_UKV;
            if (r < I_OM) { const int rb = r % 32, kb = r / 32; transpose_item(w_o_mla, D, 64 * kb, 32 * rb, 32, nullptr, Wom_t, 512, 32 * rb, scr, lane); continue; } r -= I_OM;
            if (r < I_OM) { const int rb = r % 32, kb = r / 32; transpose_item(w_o_fox, D, 64 * kb, 32 * rb, 32, nullptr, Wof_t, 512, 32 * rb, scr, lane); continue; } r -= I_OM;
            if (r < I_OUT) { const int rb = r % 32, kb = r / 32; transpose_item(w_out, D, 64 * kb, 32 * rb, 32, nullptr, Wout_t, D, 32 * rb, scr, lane); continue; } r -= I_OUT;
            if (r < I_UP) { const int rb = r % (NUP / 32), kb = r / (NUP / 32); const int d0 = 32 * rb, tt = d0 >> 8, rr = d0 & 255, sc0 = rr < 128 ? 128 * tt + rr : DFF + 128 * tt + (rr - 128);
                transpose_item(w_up, NUP, 64 * kb, sc0, 32, nullptr, Wup_t, D, d0, scr, lane); continue; } r -= I_UP;
            { const int rb = r % 32, kb = r / 32; transpose_item(w_down, D, 64 * kb, 32 * rb, 32, nullptr, Wdn_t, DFF, 32 * rb, scr, lane); }
        }
          }
    }
    SEAM(0);
    if (IN(1)) {
#pragma unroll 1
      for (int mprep = 0; mprep < MP1_REPS; ++mprep) {
        int curb = -1; f32x4 cA[4], cB[4];
        for (int mp = gw; mp < T / 4; mp += NGW) { const int m = 4 * mp, b = m >> 13;
            if (b != curb) { curb = b; const float* ad = ADA + b * 6144;
#pragma unroll
                for (int j = 0; j < 4; ++j) { const int c = 4 * (lane + 64 * j); cA[j] = *(const f32x4*)(norm_mix_g + c) * (*(const f32x4*)(ad + 1024 + c) + 1.0f); cB[j] = *(const f32x4*)(ad + c); } }
            modnorm_rows_c<4>(x + (size_t)m * D, HA + (size_t)m * D, cA, cB, lane, (size_t)D); }
          }
    }
    SEAM(1);
    if (IN(2)) {
        { pg8::Gemm g{HA, Win_t, T, NPROJ, D}; pg8::StaticOrder S; S.init(T, NPROJ, G, bid);
          EpiProj E{CQ, CKV, KR, FQ, FK, GM, GF, LF, SSQ, SSK, CS, b_forget};
#ifdef SINGLE_UNIT
          S.single = 1;
#pragma unroll 1
          for (int rd = 0; rd * G < S.nwg; ++rd) { S.base = rd; pg8::gemm_phase<EpiProj, pg8::StaticOrder, true, true>(lds, g, S, E); }
#else
          pg8::gemm_phase<EpiProj, pg8::StaticOrder, true, true>(lds, g, S, E);
#endif
        }
#ifndef NO_G2
        { pg8::Gemm g{Win_t + (size_t)NPROJ * D, HA, 512, T, D}; pg8::StaticOrder S; S.init(512, T, G, G - 1 - bid);
          EpiVt E{FVt, nullptr, 0.f};
          pg8::gemm_phase<EpiVt, pg8::StaticOrder, true, true>(lds, g, S, E); }
#endif
    }
    SEAM(2);
    if (IN(3)) {
#pragma unroll 1
      for (int smrep = 0; smrep < SM_REPS; ++smrep) {
        {
            float mq0 = 0.f, mq1 = 0.f, mk0 = 0.f, mk1 = 0.f;
            const bool light = G != 256 || (bid >= 192 && bid < 240); const int lw = G != 256 ? gw : (bid - 192) * NWAVES + wave, LNW = G != 256 ? NGW : 48 * NWAVES;
            if (light)
            for (int r0 = lw * 8; r0 < T; r0 += LNW * 8) { u32x4 qv[8], kv[8];
#pragma unroll
                for (int i = 0; i < 8; ++i) { qv[i] = *(const u32x4*)(FQ + (size_t)(r0 + i) * 512 + 8 * lane); kv[i] = *(const u32x4*)(FK + (size_t)(r0 + i) * 512 + 8 * lane); }
                float sq = 0.f, sk = 0.f;
#pragma unroll
                for (int i = 0; i < 8; ++i) { float a = 0.f, c = 0.f;
#pragma unroll
                    for (int w = 0; w < 4; ++w) { const float q0 = bflo(qv[i][w]), q1 = bfhi(qv[i][w]), k0 = bflo(kv[i][w]), k1 = bfhi(kv[i][w]); a += q0 * q0 + q1 * q1; c += k0 * k0 + k1 * k1; }
                    a += __shfl_xor(a, 1); a += __shfl_xor(a, 2); a += __shfl_xor(a, 4); c += __shfl_xor(c, 1); c += __shfl_xor(c, 2); c += __shfl_xor(c, 4);
                    sq = fmaxf(sq, a); sk = fmaxf(sk, c); }
                if (r0 >> 13) { mq1 = fmaxf(mq1, sq); mk1 = fmaxf(mk1, sk); } else { mq0 = fmaxf(mq0, sq); mk0 = fmaxf(mk0, sk); } }
            if ((lane & 7) == 0) { const int hd = lane >> 3; unsigned* N = (unsigned*)NRM;
                atomicMax(N + hd, __float_as_uint(mq0)); atomicMax(N + 8 + hd, __float_as_uint(mq1)); atomicMax(N + 16 + hd, __float_as_uint(mk0)); atomicMax(N + 24 + hd, __float_as_uint(mk1)); }
        }
#ifndef P3_NO_SCAN
        for (int sq = (G == 256 ? bid - 240 : bid); sq >= 0 && sq < 16; sq += G) {
            const int bb = sq >> 3, hh = sq & 7; LAS double* sd = (LAS double*)lds;
            double v[16]; double run = 0.0;
#pragma unroll
            for (int j = 0; j < 16; ++j) { run += (double)LF[((size_t)bb * SEQ + 16 * tid + j) * 8 + hh]; v[j] = run; }
            sd[tid] = run; __syncthreads();
            if (tid < 64) { double loc[8]; double s = 0.0;
#pragma unroll
                for (int j = 0; j < 8; ++j) { s += sd[tid * 8 + j]; loc[j] = s; }
                double incl = s;
#pragma unroll
                for (int o = 1; o < 64; o <<= 1) { const double up = __shfl_up(incl, o); if (lane >= o) incl += up; }
                const double excl = incl - s;
#pragma unroll
                for (int j = 0; j < 8; ++j) sd[512 + tid * 8 + j] = excl + loc[j]; }
            __syncthreads();
            const double off = tid ? sd[512 + tid - 1] : 0.0;
#pragma unroll
            for (int j = 0; j < 16; ++j) { const double val = -(v[j] + off) * 1.4426950408889634;
                const float f1 = (float)val; const unsigned short b1 = f2bf(f1); const double r1 = val - (double)bf2f(b1);
                const unsigned short b2 = f2bf((float)r1); const double r2 = r1 - (double)bf2f(b2); const unsigned short b3 = f2bf((float)r2);
                *(u32x4*)(FB + (((size_t)bb * SEQ + 16 * tid + j) * 8 + hh) * 8) = (u32x4){(unsigned)b1 | ((unsigned)b2 << 16), (unsigned)b3, 0u, 0u};
                NF[((size_t)bb * SEQ + 16 * tid + j) * 8 + hh] = f1; }
            __syncthreads();
        }
#endif
#ifndef P3_NO_Q
        { pg8::Gemm g{CQ, Wuq_t, T, 768, QR}; pg8::StaticOrder S; S.init(T, 768, G, bid); EpiQ E{Qb, SSQ, CS};
          pg8::gemm_phase<EpiQ, pg8::StaticOrder, true, true>(lds, g, S, E); }
#endif
#ifndef P3_NO_KN
        { pg8::Gemm g{CKV, Wukv_t, T, 512, KVR}; pg8::StaticOrder S; S.init(T, 512, G, (bid + 64) % G); EpiKN E{KN, SSK};
          pg8::gemm_phase<EpiKN, pg8::StaticOrder, true, true>(lds, g, S, E); }
#endif
#ifndef P3_NO_VMT
        { pg8::Gemm g{Wukv_t + (size_t)512 * KVR, CKV, 512, T, KVR}; pg8::StaticOrder S; S.init(512, T, G, (bid + G - 64) % G); EpiVt E{VMt, SSK, 1.0f / KVR};
          pg8::gemm_phase<EpiVt, pg8::StaticOrder, true, true>(lds, g, S, E); }
#endif
          }
    }
    SEAM(3);
    if (IN(4)) {
#ifndef ATT_REPS
#define ATT_REPS 1
#endif
        {
            volatile LAS unsigned* slot = (volatile LAS unsigned*)(lds + 131072 + 128);
            if (wave >= 4) __builtin_amdgcn_s_setprio(1);
            unsigned* qctr = (unsigned*)(ws + WS_NRM + 128);
            float bnd_l = 0.f; if (lane < 16) bnd_l = 2.02f * sqrtf(NRM[lane] * NRM[16 + lane]) + 32.0f;
#pragma unroll 1
            for (;;) {
                if (tid == 0) slot[0] = __hip_atomic_fetch_add(qctr, 1u, __ATOMIC_RELAXED, __HIP_MEMORY_SCOPE_AGENT);
                __syncthreads();
                const unsigned un = slot[0];
                __syncthreads();
                if (un >= 1024u) break;
                const int qb = 31 - (int)(un >> 5), w = (int)(un & 31), br = w >> 4, bh = w & 15, bb = bh >> 3, hh = bh & 7;
                if (br == 0) attn_unit<6, 12, 208>(lds, bb, hh, qb, Qb, 768, hh * 96, KN, 512, hh * 64, KR, 32, 0, VMt, hh * 64, OM, hh * 64, 0);
                else {
                    const int nit = 2 * qb + 2; const float nfe = lane < nit ? NF[((size_t)bb * SEQ + 128 * lane + 127) * 8 + hh] : 3.0e38f, nf0 = NF[((size_t)bb * SEQ + 256 * qb) * 8 + hh];
                    const float bound = __shfl(bnd_l, bh), lim = nf0 - bound; const bool skip = lane < nit && nfe <= lim;
                    int it0 = __builtin_amdgcn_readfirstlane(__popcll(__ballot(skip))); it0 = (it0 < nit - 2 ? it0 : nit - 2) & ~1;
                    attn_unit<5, 9, 144>(lds, bb, hh, qb, FQ, 512, hh * 64, FK, 512, hh * 64, FB, 64, hh * 8, FVt, hh * 64, OF, hh * 64, it0); }
                __syncthreads();
            }
            __builtin_amdgcn_s_setprio(0);
        }
    }
    SEAM(4);
    if (IN(5)) {
#pragma unroll 1
      for (int smrep = 0; smrep < SM_REPS; ++smrep) {
        { pg8::Gemm g{OM, Wom_t, T, D, 512}; PairOrder S; S.S0.init(T, D, G, bid); EpiGate2 E{GM, GF, Y};
          pg8::gemm_phase<EpiGate2, PairOrder, true, true>(lds, g, S, E); }

          }
    }
    SEAM(5);
    if (IN(6)) {
#pragma unroll 1
      for (int smrep = 0; smrep < SM_REPS; ++smrep) {
        pg8::Gemm g{Y, Wout_t, T, D, D}; pg8::StaticOrder S; S.init(T, D, G, bid);
        if (fusednorm) { EpiResNorm<false> E{x, out, ADA + 2048, (float*)(ws + WS_SS1), (unsigned*)(ws + WS_CNT), norm_ffn_g, ADA + 4096, ADA + 3072, H2};
            pg8::gemm_phase<EpiResNorm<false>, pg8::StaticOrder, false, true>(lds, g, S, E); }
        else { EpiRes E{x, out, ADA + 2048};
            pg8::gemm_phase<EpiRes, pg8::StaticOrder, true, true>(lds, g, S, E); }
          }
    }
    SEAM(6);
    if (IN(7) && !fusednorm) {
#pragma unroll 1
      for (int mprep = 0; mprep < MP_REPS; ++mprep) {
        for (int mp = gw; mp < T / 2; mp += NGW) { const int m = 2 * mp; const float* ad = ADA + (m >> 13) * 6144; modnorm_rows<2>(out + (size_t)m * D, H2 + (size_t)m * D, norm_ffn_g, ad + 4096, ad + 3072, lane, (size_t)D); }
          }
    }
    if (!fusednorm) SEAM(7);
    if (IN(8)) {
#pragma unroll 1
      for (int rep8 = 0; rep8 < P8_REPS; ++rep8) {
        pg8::Gemm g{H2, Wup_t, T, NUP, D}; pg8::StaticOrder S; S.init(T, NUP, G, bid); EpiConv E{ACT, HALO, PART, conv_w, conv_b};
        pg8::gemm_phase<EpiConv, pg8::StaticOrder, true, true>(lds, g, S, E);
      }
    }
    SEAM(8);
    if (IN(9)) {
        for (int i = bid * NTHR + tid; i < 256 * 2 * (DFF / 4); i += G * NTHR) {
            const int c4 = i % (DFF / 4), rr = (i / (DFF / 4)) & 1, grp = i / (2 * (DFF / 4)), ng = 4 * c4;
            f32x4 cgv = *(const f32x4*)(PART + ((size_t)grp * 2 + rr) * NUP + ng), cvv = *(const f32x4*)(PART + ((size_t)grp * 2 + rr) * NUP + DFF + ng);
            if (grp & 127) {
                const float* H = HALO + (size_t)(grp - 1) * 2 * NUP;
                const f32x4 wg0 = *(const f32x4*)(conv_w + ng), wg1 = *(const f32x4*)(conv_w + NUP + ng), wv0 = *(const f32x4*)(conv_w + DFF + ng), wv1 = *(const f32x4*)(conv_w + NUP + DFF + ng);
                const f32x4 hg0 = *(const f32x4*)(H + ng), hg1 = *(const f32x4*)(H + NUP + ng), hv0 = *(const f32x4*)(H + DFF + ng), hv1 = *(const f32x4*)(H + NUP + DFF + ng);
                if (rr == 0) { cgv += wg0 * hg0 + wg1 * hg1; cvv += wv0 * hv0 + wv1 * hv1; }
                else { cgv += wg0 * hg1; cvv += wv0 * hv1; }
            }
            f32x4 a;
#pragma unroll
            for (int j = 0; j < 4; ++j) a[j] = siluf_(cgv[j]) * cvv[j];
            *(u32x2*)(ACT + (size_t)(64 * grp + rr) * DFF + ng) = pack4(a);
        }
    }
    SEAM(9);
    if (IN(10)) {
        pg8::Gemm g{ACT, Wdn_t, T, D, DFF}; pg8::StaticOrder S; S.init(T, D, G, bid);
        if (fusednorm) { EpiResNorm<true> E{out, out, ADA + 5120, (float*)(ws + WS_SS2), (unsigned*)(ws + WS_CNT) + 64 * 64, norm_final_g, nullptr, nullptr, nullptr};
            pg8::gemm_phase<EpiResNorm<true>, pg8::StaticOrder, false, true>(lds, g, S, E); }
        else { EpiRes E{out, out, ADA + 5120};
            pg8::gemm_phase<EpiRes, pg8::StaticOrder, true, true>(lds, g, S, E); }
    }
    if (!fusednorm) SEAM(10);
    if (IN(11) && !fusednorm) {
        for (int mp = gw; mp < T / 2; mp += NGW) { float* row = out + (size_t)(2 * mp) * D; f32x4 v[2][4]; float s[2];
#pragma unroll
            for (int q = 0; q < 2; ++q)
#pragma unroll
                for (int j = 0; j < 4; ++j) v[q][j] = *((const f32x4*)(row + q * D) + lane + 64 * j);
#pragma unroll
            for (int q = 0; q < 2; ++q) { s[q] = 0.f;
#pragma unroll
                for (int j = 0; j < 4; ++j) s[q] += (v[q][j][0] * v[q][j][0] + v[q][j][1] * v[q][j][1]) + (v[q][j][2] * v[q][j][2] + v[q][j][3] * v[q][j][3]); }
#pragma unroll
            for (int q = 0; q < 2; ++q) { const float rstd = __builtin_amdgcn_rsqf(wave_sum(s[q]) * (1.0f / D) + EPS);
#pragma unroll
                for (int j = 0; j < 4; ++j) { const f32x4 gg = *((const f32x4*)norm_final_g + lane + 64 * j); *((f32x4*)(row + q * D) + lane + 64 * j) = v[q][j] * rstd * gg; } } }
    }
#undef IN
#undef SEAM
}


#ifdef DBG_STOP
__global__ void dump_kernel(float* out, const unsigned short* src, size_t ne, const unsigned short* src2) {
    const size_t N = (size_t)T * D;
    for (size_t i = (size_t)blockIdx.x * blockDim.x + threadIdx.x; i < N; i += (size_t)gridDim.x * blockDim.x)
        out[i] = i < ne ? bf2f(src[i]) : (src2 && i - ne < ne ? bf2f(src2[i - ne]) : 0.f);
}
#endif
#ifndef MK_ONE_LAUNCH
#define MK_ONE_LAUNCH 1
#endif
extern "C" void kernel_launch(void* const* d_in, const int* in_sizes, int n_in, void* d_out, int out_size, void* d_ws, size_t ws_size, hipStream_t stream) {
    static int grid = 0;
    const void* kfn = (const void*)mk_fwd<0xFFFu>;
    if (grid == 0) {
        int dev = 0, cus = 0, per_cu = 0;
        (void)hipGetDevice(&dev); (void)hipDeviceGetAttribute(&cus, hipDeviceAttributeMultiprocessorCount, dev);
        if (hipFuncSetAttribute(kfn, hipFuncAttributeMaxDynamicSharedMemorySize, LDS_BYTES) != hipSuccess) { fprintf(stderr, "hipFuncSetAttribute failed\n"); grid = -1; return; }
        if (hipOccupancyMaxActiveBlocksPerMultiprocessor(&per_cu, kfn, NTHR, LDS_BYTES) != hipSuccess || per_cu < 1) { fprintf(stderr, "occupancy query: %d\n", per_cu); per_cu = 1; }
        (void)hipGetLastError();
        grid = cus * per_cu;
        fprintf(stderr, "mk_fwd: grid %d (cus %d x %d), ws %zu\n", grid, cus, per_cu, ws_size);
    }
    if (grid < 0) return;
    (void)hipMemsetAsync((unsigned char*)d_ws + ZERO_OFF, 0, ZERO_BYTES, stream);
    Args a{};
    for (int i = 0; i < 21; ++i) a.in[i] = d_in[i];
    a.out = (float*)d_out; a.ws = (unsigned char*)d_ws;
#if MK_ONE_LAUNCH
    a.ph_lo = 0; a.ph_hi = NPH;
    void* kargs[] = {&a};
    hipError_t e = hipLaunchCooperativeKernel(kfn, dim3(grid), dim3(NTHR), kargs, LDS_BYTES, stream);
    if (e != hipSuccess) fprintf(stderr, "cooperative launch failed: %s (grid %d)\n", hipGetErrorString(e), grid);
#else
#define MK_L(ph) do { a.ph_lo = ph; a.ph_hi = ph + 1; (void)hipFuncSetAttribute((const void*)mk_fwd<(1u << ph)>, hipFuncAttributeMaxDynamicSharedMemorySize, LDS_BYTES); hipLaunchKernelGGL(mk_fwd<(1u << ph)>, dim3(grid), dim3(NTHR), LDS_BYTES, stream, a); } while (0)
#ifdef DBG_STOP
#define MK_LD(ph) do { if (ph < DBG_STOP) MK_L(ph); } while (0)
#ifdef P5_ONLY_G7
#define P5_ONLY 1
#else
#define P5_ONLY 0
#endif
#ifdef P5_SPLIT
#undef MK_LD
#define MK_LD(ph) do { if (ph < DBG_STOP) { if (ph == 5) { (void)hipFuncSetAttribute((const void*)mk_fwd<32u>, hipFuncAttributeMaxDynamicSharedMemorySize, LDS_BYTES); a.ph_lo = 5; a.ph_hi = 6 | 0x100; hipLaunchKernelGGL(mk_fwd<32u>, dim3(grid), dim3(NTHR), LDS_BYTES, stream, a); a.ph_hi = 6 | 0x200; if (!P5_ONLY) hipLaunchKernelGGL(mk_fwd<32u>, dim3(grid), dim3(NTHR), LDS_BYTES, stream, a); } else MK_L(ph); } } while (0)
#endif
    MK_LD(0); MK_LD(1); MK_LD(2); MK_LD(3); MK_LD(4); MK_LD(5); MK_LD(6); MK_LD(7); MK_LD(8); MK_LD(9); MK_LD(10); MK_LD(11);
#ifdef DUMP_OFF
    hipLaunchKernelGGL(dump_kernel, dim3(2048), dim3(256), 0, stream, (float*)d_out, (const unsigned short*)((const unsigned char*)d_ws + (size_t)(DUMP_OFF) * MiB), (size_t)(DUMP_MIB) * MiB / 2,
#ifdef DUMP_OFF2
        (const unsigned short*)((const unsigned char*)d_ws + (size_t)(DUMP_OFF2) * MiB));
#else
        (const unsigned short*)nullptr);
#endif
#endif
#else
    MK_L(0); MK_L(1); MK_L(2); MK_L(3); MK_L(4); MK_L(5); MK_L(6); MK_L(7); MK_L(8); MK_L(9); MK_L(10); MK_L(11);
#endif
#undef MK_L
#endif
}
```
